# Optimizing an MI355X kernel written in HIP

```python
import math
import jax, jax.numpy as jnp
from jax import lax
import numpy as np

D_MODEL = 1024
BATCH = 4
SEQ = 4096
DEPTH = 2
DEC_BATCH = 128
DEC_SEQ = 8
PAST_LEN = 16384
PAGE_SIZE = 128

HEAD_DIM = 64
GMLP_HEADS = 8
GMLP_WIDTH = GMLP_HEADS * HEAD_DIM
CHUNK = 128
ATTN_HEADS = 8
KV_HEADS = 2
GQA_GROUP = ATTN_HEADS // KV_HEADS
ATTN_WIDTH = ATTN_HEADS * HEAD_DIM
KV_WIDTH = KV_HEADS * HEAD_DIM
WINDOW = 128
ROPE_THETA = 10000.0
MIX_WIDTH = GMLP_WIDTH + ATTN_WIDTH
IN_WIDTH = 2 * GMLP_WIDTH + ATTN_WIDTH + 2 * KV_WIDTH
D_FF = 2816
CONV_WIDTH = 3
LN_EPS = 1e-5
DEEPNORM_ALPHA = (2.0 * DEPTH) ** 0.25
DEEPNORM_BETA = (8.0 * DEPTH) ** -0.25
NEG_INF = -1e30

kernel_name = "hybrid_gmlp_swa_sink_convffn_deepnorm_step"


def layer_norm(x, g, b):
    xf = x.astype(jnp.float32)
    mu = jnp.mean(xf, axis=-1, keepdims=True)
    var = jnp.mean(jnp.square(xf - mu), axis=-1, keepdims=True)
    y = (xf - mu) * lax.rsqrt(var + LN_EPS)
    return (y * g.astype(jnp.float32) + b.astype(jnp.float32)).astype(x.dtype)


def rotary(x, pos):
    half = HEAD_DIM // 2
    inv_freq = ROPE_THETA ** (-jnp.arange(half, dtype=jnp.float32) / half)
    ang = pos.astype(jnp.float32)[:, None] * inv_freq[None, :]
    cos = jnp.cos(ang)[:, None, :]
    sin = jnp.sin(ang)[:, None, :]
    xf = x.astype(jnp.float32)
    x1, x2 = xf[..., :half], xf[..., half:]
    out = jnp.concatenate([x1 * cos - x2 * sin, x2 * cos + x1 * sin], axis=-1)
    return out.astype(x.dtype)


def chunk_spatial(v, w_s, b_s):
    L = v.shape[-3]
    wm = jnp.where(jnp.tril(jnp.ones((L, L), dtype=bool)), w_s, 0.0)
    return jnp.einsum('hts,...shc->...thc', wm.astype(v.dtype), v) + b_s.T[:, :, None].astype(v.dtype)


def sink_attention(q, k, v, q_pos, k_pos, sinks):
    scale = HEAD_DIM ** -0.5
    s = jnp.einsum('...qhgd,...shd->...hgqs', q, k).astype(jnp.float32) * scale
    diff = q_pos[..., :, None] - k_pos[..., None, :]
    mask = (diff >= 0) & (diff < WINDOW) & (k_pos[..., None, :] >= 0)
    s = jnp.where(mask[..., None, None, :, :], s, NEG_INF)
    sink = sinks.astype(jnp.float32).reshape(KV_HEADS, GQA_GROUP)[:, :, None, None]
    m = jnp.maximum(jnp.max(s, axis=-1, keepdims=True), sink)
    p = jnp.exp(s - m)
    denom = jnp.sum(p, axis=-1, keepdims=True) + jnp.exp(sink - m)
    p = (p / denom).astype(v.dtype)
    return jnp.einsum('...hgqs,...shd->...qhgd', p, v).astype(q.dtype)


def trunk_layer(x, pos, is_prompt, swa_k_prev, swa_v_prev, conv_prev,
                w_in, gmlp_ln_g, gmlp_ln_b, w_spatial, b_spatial, attn_sinks, w_out,
                ln1_g, ln1_b, w_up, conv_w, conv_b, w_down, ln2_g, ln2_b):
    Bn, T, _ = x.shape
    h = jnp.einsum('btd,de->bte', x, w_in)
    o1 = GMLP_WIDTH
    o2 = o1 + GMLP_WIDTH
    o3 = o2 + ATTN_WIDTH
    o4 = o3 + KV_WIDTH
    z_u = jax.nn.gelu(h[..., :o1], approximate=False).reshape(Bn, T, GMLP_HEADS, HEAD_DIM)
    z_v = jax.nn.gelu(h[..., o1:o2], approximate=False).reshape(Bn, T, GMLP_HEADS, HEAD_DIM)
    z_v = layer_norm(z_v, gmlp_ln_g, gmlp_ln_b)
    q = rotary(h[..., o2:o3].reshape(Bn, T, ATTN_HEADS, HEAD_DIM), pos)
    k = rotary(h[..., o3:o4].reshape(Bn, T, KV_HEADS, HEAD_DIM), pos)
    v = h[..., o4:].reshape(Bn, T, KV_HEADS, HEAD_DIM)

    if is_prompt:
        nc = T // CHUNK
        f = chunk_spatial(z_v.reshape(Bn, nc, CHUNK, GMLP_HEADS, HEAD_DIM), w_spatial, b_spatial)
        f = f.reshape(Bn, T, GMLP_HEADS, HEAD_DIM)
        nb = T // WINDOW
        qb = q.reshape(Bn, nb, WINDOW, KV_HEADS, GQA_GROUP, HEAD_DIM)
        k_cur = k.reshape(Bn, nb, WINDOW, KV_HEADS, HEAD_DIM)
        v_cur = v.reshape(Bn, nb, WINDOW, KV_HEADS, HEAD_DIM)
        k_prev = jnp.concatenate([jnp.zeros_like(k_cur[:, :1]), k_cur[:, :-1]], axis=1)
        v_prev = jnp.concatenate([jnp.zeros_like(v_cur[:, :1]), v_cur[:, :-1]], axis=1)
        k_band = jnp.concatenate([k_prev, k_cur], axis=2)
        v_band = jnp.concatenate([v_prev, v_cur], axis=2)
        start = jnp.arange(nb, dtype=jnp.int32) * WINDOW
        q_pos = start[:, None] + jnp.arange(WINDOW, dtype=jnp.int32)[None, :]
        k_pos = start[:, None] + jnp.arange(-WINDOW, WINDOW, dtype=jnp.int32)[None, :]
        attn = sink_attention(qb, k_band, v_band, q_pos, k_pos, attn_sinks)
        attn = attn.reshape(Bn, T, ATTN_HEADS, HEAD_DIM)
        new_k = k[:, -WINDOW:]
        new_v = v[:, -WINDOW:]
        conv_prefix = jnp.zeros((Bn, CONV_WIDTH - 1, 2 * D_FF), x.dtype)
    else:
        f = chunk_spatial(z_v, w_spatial[:, :T, :T], b_spatial[:, :T])
        qs = q.reshape(Bn, T, KV_HEADS, GQA_GROUP, HEAD_DIM)
        k_all = jnp.concatenate([swa_k_prev, k], axis=1)
        v_all = jnp.concatenate([swa_v_prev, v], axis=1)
        k_pos = jnp.concatenate([pos[0] - WINDOW + jnp.arange(WINDOW, dtype=jnp.int32), pos])
        attn = sink_attention(qs, k_all, v_all, pos, k_pos, attn_sinks)
        attn = attn.reshape(Bn, T, ATTN_HEADS, HEAD_DIM)
        new_k = k_all[:, -WINDOW:]
        new_v = v_all[:, -WINDOW:]
        conv_prefix = conv_prev

    gmlp_out = (z_u * f).reshape(Bn, T, GMLP_WIDTH)
    mix = jnp.concatenate([gmlp_out, attn.reshape(Bn, T, ATTN_WIDTH)], axis=-1)
    mix = jnp.einsum('bte,ed->btd', mix, w_out)
    x = layer_norm(DEEPNORM_ALPHA * x + mix, ln1_g, ln1_b)

    up = jnp.einsum('btd,df->btf', x, w_up)
    hp = jnp.concatenate([conv_prefix, up], axis=1)
    hc = conv_b + sum(conv_w[i] * hp[:, i:i + T] for i in range(CONV_WIDTH))
    new_conv = hp[:, -(CONV_WIDTH - 1):]
    g, u = hc[..., :D_FF], hc[..., D_FF:]
    y = jnp.einsum('btf,fd->btd', jax.nn.gelu(g, approximate=False) * u, w_down)
    x = layer_norm(DEEPNORM_ALPHA * x + y, ln2_g, ln2_b)
    return x, new_k, new_v, new_conv, z_v


def setup_inputs(seed: int = 0) -> dict:
    key = jax.random.key(seed)
    ks = jax.random.split(key, 24)

    def nrm(k, shape, scale):
        return jax.random.normal(k, shape, jnp.float32) * scale

    return {
        "x_prompt": nrm(ks[0], (BATCH, SEQ, D_MODEL), 1.0),
        "x_sample": nrm(ks[1], (DEC_BATCH, DEC_SEQ, D_MODEL), 1.0),
        "cache_swa_k": nrm(ks[2], (DEPTH, DEC_BATCH, WINDOW, KV_HEADS, HEAD_DIM), 1.0),
        "cache_swa_v": nrm(ks[3], (DEPTH, DEC_BATCH, WINDOW, KV_HEADS, HEAD_DIM), 1.0),
        "cache_conv": nrm(ks[4], (DEPTH, DEC_BATCH, CONV_WIDTH - 1, 2 * D_FF), 1.0),
        "w_in": nrm(ks[5], (DEPTH, D_MODEL, IN_WIDTH), D_MODEL ** -0.5),
        "gmlp_ln_g": 1.0 + nrm(ks[6], (DEPTH, GMLP_HEADS, HEAD_DIM), 0.02),
        "gmlp_ln_b": nrm(ks[7], (DEPTH, GMLP_HEADS, HEAD_DIM), 0.02),
        "w_spatial": nrm(ks[8], (DEPTH, GMLP_HEADS, CHUNK, CHUNK), 0.5 * CHUNK ** -0.5),
        "b_spatial": 1.0 + nrm(ks[9], (DEPTH, GMLP_HEADS, CHUNK), 0.02),
        "attn_sinks": nrm(ks[10], (DEPTH, ATTN_HEADS), 0.5),
        "w_out": nrm(ks[11], (DEPTH, MIX_WIDTH, D_MODEL), MIX_WIDTH ** -0.5 * DEEPNORM_BETA),
        "ln1_g": 1.0 + nrm(ks[12], (DEPTH, D_MODEL), 0.02),
        "ln1_b": nrm(ks[13], (DEPTH, D_MODEL), 0.02),
        "w_up": nrm(ks[14], (DEPTH, D_MODEL, 2 * D_FF), D_MODEL ** -0.5),
        "conv_w": nrm(ks[15], (DEPTH, CONV_WIDTH, 2 * D_FF), CONV_WIDTH ** -0.5),
        "conv_b": nrm(ks[16], (DEPTH, 2 * D_FF), 0.02),
        "w_down": nrm(ks[17], (DEPTH, D_FF, D_MODEL), D_FF ** -0.5 * DEEPNORM_BETA),
        "ln2_g": 1.0 + nrm(ks[18], (DEPTH, D_MODEL), 0.02),
        "ln2_b": nrm(ks[19], (DEPTH, D_MODEL), 0.02),
    }


def reference(x_prompt, x_sample, cache_swa_k, cache_swa_v, cache_conv,
              w_in, gmlp_ln_g, gmlp_ln_b, w_spatial, b_spatial, attn_sinks, w_out,
              ln1_g, ln1_b, w_up, conv_w, conv_b, w_down, ln2_g, ln2_b):
    pos_prompt = jnp.arange(x_prompt.shape[1], dtype=jnp.int32)
    pos_sample = PAST_LEN + jnp.arange(x_sample.shape[1], dtype=jnp.int32)
    xp, xs = x_prompt, x_sample
    kp_list, vp_list, cp_list = [], [], []
    ks_list, vs_list, cs_list, gs_list = [], [], [], []
    for l in range(DEPTH):
        weights = (w_in[l], gmlp_ln_g[l], gmlp_ln_b[l], w_spatial[l], b_spatial[l], attn_sinks[l],
                   w_out[l], ln1_g[l], ln1_b[l], w_up[l], conv_w[l], conv_b[l], w_down[l],
                   ln2_g[l], ln2_b[l])
        xp, kp, vp, cp, _ = trunk_layer(xp, pos_prompt, True, None, None, None, *weights)
        xs, kn, vn, cn, gv = trunk_layer(xs, pos_sample, False, cache_swa_k[l], cache_swa_v[l],
                                         cache_conv[l], *weights)
        kp_list.append(kp)
        vp_list.append(vp)
        cp_list.append(cp)
        ks_list.append(kn)
        vs_list.append(vn)
        cs_list.append(cn)
        gs_list.append(gv)
    new_swa_k_prompt = jnp.stack(kp_list, axis=0)
    new_swa_v_prompt = jnp.stack(vp_list, axis=0)
    new_conv_prompt = jnp.stack(cp_list, axis=0)
    new_swa_k_sample = jnp.stack(ks_list, axis=0)
    new_swa_v_sample = jnp.stack(vs_list, axis=0)
    new_conv_sample = jnp.stack(cs_list, axis=0)
    new_gmlp_v_sample = jnp.stack(gs_list, axis=0)
    return (xp, xs, new_swa_k_prompt, new_swa_v_prompt, new_conv_prompt,
            new_swa_k_sample, new_swa_v_sample, new_conv_sample, new_gmlp_v_sample)
```

```cpp
#define NO_XCHG 1
#include <hip/hip_runtime.h>
#include <cstdio>
#include <cstdint>
#include <cmath>

namespace cfg {
constexpr int D = 1024, NIN = 1792, FF = 2816, NUP = 5632, MP = 16384, MS = 1024, M = MP + MS, SEQ = 4096;
constexpr size_t O_Y = 0, O_KP = 17825792, O_VP = 17956864, O_CP = 18087936, O_KS = 18178048, O_VS = 22372352, O_CS = 26566656, O_GS = 29450240, O_END = 30498816;
constexpr float ALPHA = 1.41421356237309515f, LN_EPS = 1e-5f;
}
namespace pg8 {
#define PG8_LAS __attribute__((address_space(3)))
typedef unsigned short bf16_t;
typedef short bf16x8 __attribute__((ext_vector_type(8)));
typedef float f32x4 __attribute__((ext_vector_type(4)));
typedef unsigned u32x4 __attribute__((ext_vector_type(4)));
constexpr int BM = 256, BK = 64, HALF = 128, HTB = HALF * BK * 2  , STAGE_BYTES = 8 * HTB, NXCD = 8, WGM = 8;

__host__ __device__ __forceinline__ int lds_byte(int r, int c) { const int st = (r >> 4) * 2 + (c >> 5), rr = r & 15, cc = c & 31, ob = rr * 64 + cc * 2; return st * 1024 + (ob ^ (((ob >> 9) & 1) << 5)); }
__host__ __device__ __forceinline__ void stage_rc(int b, int& R, int& C) { const int st = b / 1024, sb = b % 1024, swz = sb ^ (((sb >> 9) & 1) << 5); R = (st >> 1) * 16 + swz / 64; C = (st & 1) * 32 + (swz % 64) / 2; }
__host__ __device__ __forceinline__ int perm32(int rho) { const int n = rho >> 4, i = rho & 15; return 8 * (i >> 2) + 4 * n + (i & 3); }

struct Unit { int pm, pn; };
struct Gemm { const bf16_t* A; const bf16_t* Bt; int M, N, K; };

struct StaticOrder {
    int nM, nN, nwg, G, c;
    __host__ __device__ void init(int M, int N, int G_, int c_) { nM = M / BM; nN = N / BM; nwg = nM * nN; G = G_; c = c_; }
    __host__ __device__ bool next(int i, Unit& u) const {
        const long L = (long)i * G + c; if (L >= nwg) return false;
        int wgid = (int)L; { const int q = nwg / NXCD, r = nwg % NXCD, xcd = wgid % NXCD, off = wgid / NXCD; wgid = (xcd < r ? xcd * (q + 1) : r * (q + 1) + (xcd - r) * q) + off; }
        const int nig = WGM * nN, gid = wgid / nig, fm = gid * WGM, gsz = (nM - fm) < WGM ? (nM - fm) : WGM;
        u.pm = fm + ((wgid % nig) % gsz); u.pn = (wgid % nig) / gsz; return true;
    }
    __device__ __forceinline__ void a_ready(const Unit&) const {}
    __device__ __forceinline__ void done(const Unit&) const {}
};

__device__ __forceinline__ unsigned cvt_pk_bf16(float lo, float hi) { unsigned r; asm volatile("v_cvt_pk_bf16_f32 %0, %1, %2" : "=v"(r) : "v"(lo), "v"(hi)); return r; }
typedef float f32x2 __attribute__((ext_vector_type(2)));
__device__ __forceinline__ f32x2 gelu_pk(f32x2 v) {
    const f32x2 av = __builtin_elementwise_abs(v), d = av * 0.2316418882f + 1.0f;
    f32x2 t; t.x = __builtin_amdgcn_rcpf(d.x); t.y = __builtin_amdgcn_rcpf(d.y);
    f32x2 q = t * 0.5307027145f + (-0.7265760135f); q = q * t + 0.7107068705f; q = q * t + (-0.142248368f); q = q * t + 0.127414796f; q = q * t;
    const f32x2 s = (v * v) * (-0.72134752044f);
    f32x2 e; e.x = __builtin_amdgcn_exp2f(s.x); e.y = __builtin_amdgcn_exp2f(s.y);
    const f32x2 m = v * (q * e), r = v - m;
    f32x2 o; o.x = v.x < 0.f ? m.x : r.x; o.y = v.y < 0.f ? m.y : r.y; return o;
}

typedef unsigned u32x2 __attribute__((ext_vector_type(2)));
__device__ __forceinline__ f32x4 gelu4(f32x4 v) { const f32x2 a = gelu_pk((f32x2){v[0], v[1]}), b = gelu_pk((f32x2){v[2], v[3]}); return (f32x4){a.x, a.y, b.x, b.y}; }
__device__ __forceinline__ u32x4 pack8(f32x4 a, f32x4 b) { u32x4 w; w.x = cvt_pk_bf16(a[0], a[1]); w.y = cvt_pk_bf16(a[2], a[3]); w.z = cvt_pk_bf16(b[0], b[1]); w.w = cvt_pk_bf16(b[2], b[3]); return w; }
__device__ __forceinline__ float sum4(f32x4 v) { return (v[0] + v[1]) + (v[2] + v[3]); }

struct EpiIn {
    static constexpr bool PERM = false, AFTER_DRAIN = false;
    bf16_t* MIX; bf16_t* ZV; bf16_t* KB; bf16_t* VB; const float* rope; const float* lng; const float* lnb; float* out; int layer;
    __device__ __forceinline__ void operator()(const f32x4 (&acc)[2][2][4][2], const Unit& u, int wr, int wc, int fr_, int fq_) const {
        int fr = fr_, fq = fq_; asm volatile("" : "+v"(fr), "+v"(fq) :: "memory");
        const int hg = 4 * u.pn + wc, dcol = 8 * fq, layer_ = layer;
        if (hg < 8) {
#pragma unroll
            for (int ai = 0; ai < 2; ++ai)
#pragma unroll
                for (int m = 0; m < 4; ++m) { const int row = u.pm * 256 + ai * 128 + wr * 64 + m * 16 + fr; bf16_t* rp = MIX + (size_t)row * 1024 + 64 * hg + dcol;
#pragma unroll
                    for (int bj = 0; bj < 2; ++bj) *(u32x4*)(rp + 32 * bj) = pack8(gelu4(acc[ai][bj][m][0]), gelu4(acc[ai][bj][m][1])); }
        } else if (hg < 16) {
            const int h = hg - 8;
            f32x4 gw[2][2], gb[2][2];
#pragma unroll
            for (int bj = 0; bj < 2; ++bj)
#pragma unroll
                for (int n = 0; n < 2; ++n) { gw[bj][n] = *(const f32x4*)(lng + h * 64 + 32 * bj + dcol + 4 * n); gb[bj][n] = *(const f32x4*)(lnb + h * 64 + 32 * bj + dcol + 4 * n); }
#pragma unroll
            for (int ai = 0; ai < 2; ++ai)
#pragma unroll
                for (int m = 0; m < 4; ++m) { const int row = u.pm * 256 + ai * 128 + wr * 64 + m * 16 + fr;
                    f32x4 g[2][2]; float s = 0.f;
#pragma unroll
                    for (int bj = 0; bj < 2; ++bj)
#pragma unroll
                        for (int n = 0; n < 2; ++n) { g[bj][n] = gelu4(acc[ai][bj][m][n]); s += sum4(g[bj][n]); }
                    s += __shfl_xor(s, 16); s += __shfl_xor(s, 32);
                    const float mean = s * (1.0f / 64.0f); float q = 0.f;
#pragma unroll
                    for (int bj = 0; bj < 2; ++bj)
#pragma unroll
                        for (int n = 0; n < 2; ++n) { g[bj][n] = g[bj][n] - mean; q += sum4(g[bj][n] * g[bj][n]); }
                    q += __shfl_xor(q, 16); q += __shfl_xor(q, 32);
                    const float rstd = 1.0f / sqrtf(q * (1.0f / 64.0f) + cfg::LN_EPS);
#pragma unroll
                    for (int bj = 0; bj < 2; ++bj)
#pragma unroll
                        for (int n = 0; n < 2; ++n) g[bj][n] = g[bj][n] * rstd * gw[bj][n] + gb[bj][n];
                    bf16_t* rp = ZV + (size_t)row * 512 + 64 * h + dcol;
#pragma unroll
                    for (int bj = 0; bj < 2; ++bj) *(u32x4*)(rp + 32 * bj) = pack8(g[bj][0], g[bj][1]);
                    if (row >= cfg::MP) { float* op = out + cfg::O_GS + ((size_t)(layer_ * 1024 + (row - cfg::MP))) * 512 + 64 * h + dcol;
#pragma unroll
                        for (int bj = 0; bj < 2; ++bj)
#pragma unroll
                            for (int n = 0; n < 2; ++n) *(f32x4*)(op + 32 * bj + 4 * n) = g[bj][n]; }
                }
        } else {
            const bool isv = hg >= 26, isq = hg < 24;
#pragma unroll
            for (int ai = 0; ai < 2; ++ai)
#pragma unroll
                for (int m = 0; m < 4; ++m) { const int row = u.pm * 256 + ai * 128 + wr * 64 + m * 16 + fr;
                    f32x4 o[2][2];
                    if (!isv) { const int p = row < cfg::MP ? (row & 4095) : 4096 + (row & 7);
#pragma unroll
                        for (int n = 0; n < 2; ++n) { const f32x4* rp = (const f32x4*)(rope + ((size_t)p * 32 + dcol + 4 * n) * 2); const f32x4 cs0 = rp[0], cs1 = rp[1];
                            const f32x4 c = (f32x4){cs0[0], cs0[2], cs1[0], cs1[2]}, s = (f32x4){cs0[1], cs0[3], cs1[1], cs1[3]}; const f32x4 x1 = acc[ai][0][m][n], x2 = acc[ai][1][m][n];
                            o[0][n] = x1 * c - x2 * s; o[1][n] = x2 * c + x1 * s; }
                    } else {
#pragma unroll
                        for (int bj = 0; bj < 2; ++bj)
#pragma unroll
                            for (int n = 0; n < 2; ++n) o[bj][n] = acc[ai][bj][m][n]; }
                    if (isq) { bf16_t* rp = MIX + (size_t)row * 1024 + 512 + 64 * (hg - 16) + dcol;
#pragma unroll
                        for (int bj = 0; bj < 2; ++bj) *(u32x4*)(rp + 32 * bj) = pack8(o[bj][0] * 0.125f, o[bj][1] * 0.125f);
                    } else { const int kvh = (hg - 24) & 1; bf16_t* rp = (isv ? VB : KB) + (size_t)row * 128 + 64 * kvh + dcol;
#pragma unroll
                        for (int bj = 0; bj < 2; ++bj) *(u32x4*)(rp + 32 * bj) = pack8(o[bj][0], o[bj][1]);
                        float* op = nullptr;
                        if (row < cfg::MP) { const int pos = row & 4095; if (pos >= 3968) op = out + (isv ? cfg::O_VP : cfg::O_KP) + ((size_t)((layer_ * 4 + (row >> 12)) * 128 + (pos - 3968)) * 2 + kvh) * 64 + dcol; }
                        else { const int sr = row - cfg::MP; op = out + (isv ? cfg::O_VS : cfg::O_KS) + ((size_t)((layer_ * 128 + (sr >> 3)) * 128 + 120 + (sr & 7)) * 2 + kvh) * 64 + dcol; }
                        if (op) {
#pragma unroll
                            for (int bj = 0; bj < 2; ++bj)
#pragma unroll
                                for (int n = 0; n < 2; ++n) *(f32x4*)(op + 32 * bj + 4 * n) = o[bj][n]; }
                    }
                }
        }
    }
};

struct EpiRes {
    static constexpr bool PERM = false, AFTER_DRAIN = false;
    const float* resP; const float* resS; float* Y;
    __device__ __forceinline__ void operator()(const f32x4 (&acc)[2][2][4][2], const Unit& u, int wr, int wc, int fr_, int fq_) const {
        int fr = fr_, fq = fq_; asm volatile("" : "+v"(fr), "+v"(fq) :: "memory");
        const int col0 = u.pn * 256 + wc * 32 + 4 * fq;
#pragma unroll
        for (int ai = 0; ai < 2; ++ai)
#pragma unroll
            for (int m = 0; m < 4; ++m) { const int row = u.pm * 256 + ai * 128 + wr * 64 + m * 16 + fr;
                const float* rp = (row < cfg::MP ? resP + (size_t)row * 1024 : resS + (size_t)(row - cfg::MP) * 1024) + col0; float* yp = Y + (size_t)row * 1024 + col0;
                f32x4 x[2][2];
#pragma unroll
                for (int bj = 0; bj < 2; ++bj)
#pragma unroll
                    for (int n = 0; n < 2; ++n) x[bj][n] = *(const f32x4*)(rp + bj * 128 + n * 16);
#pragma unroll
                for (int bj = 0; bj < 2; ++bj)
#pragma unroll
                    for (int n = 0; n < 2; ++n) *(f32x4*)(yp + bj * 128 + n * 16) = x[bj][n] * cfg::ALPHA + acc[ai][bj][m][n];
            }
    }
};

struct EpiUp {
    static constexpr bool PERM = false, AFTER_DRAIN = false;
    bf16_t* ACT; const float* cw; const float* cb; float* UPS; float* out; float* HF; float* HL; PG8_LAS unsigned char* xl; int layer;
    __device__ __forceinline__ void operator()(const f32x4 (&acc)[2][2][4][2], const Unit& u, int wr, int wc, int fr_, int fq_) const {
        int fr = fr_, fq = fq_; asm volatile("" : "+v"(fr), "+v"(fq) :: "memory");
        const int wid = wr * 4 + wc, lane = fq * 16 + fr, pm = u.pm, pn = u.pn, layer_ = layer;
        const int gcol = 128 * pn + 32 * wc + 8 * fq;
        PG8_LAS f32x4* X = (PG8_LAS f32x4*)xl;
#define EPIUP_SHF(v, l) __builtin_bit_cast(float, __builtin_amdgcn_ds_bpermute((l), __builtin_bit_cast(int, (v))))
        if (pm >= 64) {
#pragma unroll
            for (int ai = 0; ai < 2; ++ai)
#pragma unroll
                for (int m = 0; m < 4; ++m) { float* rp = UPS + (size_t)(pm * 256 + ai * 128 + wr * 64 + m * 16 + fr - cfg::MP) * 5632 + gcol;
#pragma unroll
                    for (int bj = 0; bj < 2; ++bj)
#pragma unroll
                        for (int n = 0; n < 2; ++n) *(f32x4*)(rp + bj * 2816 + 4 * n) = acc[ai][bj][m][n]; }
            return;
        }
        if (fr >= 14) {
#pragma unroll
            for (int ai = 0; ai < 2; ++ai)
#pragma unroll
                for (int bj = 0; bj < 2; ++bj)
#pragma unroll
                    for (int n = 0; n < 2; ++n) X[((((wid * 2 + ai) * 2 + bj) * 2 + n) * 4 + fq) * 2 + (fr - 14)] = acc[ai][bj][3][n];
        }
        {
#pragma unroll
            for (int ai = 0; ai < 2; ++ai) { const int q = pm * 4 + ai * 2 + wr;
                if (fr < 2) {
#pragma unroll
                    for (int bj = 0; bj < 2; ++bj)
#pragma unroll
                        for (int n = 0; n < 2; ++n) *(f32x4*)(HF + (size_t)(q * 2 + fr) * 5632 + bj * 2816 + gcol + 4 * n) = acc[ai][bj][0][n];
                }
                if (fr >= 14) {
#pragma unroll
                    for (int bj = 0; bj < 2; ++bj)
#pragma unroll
                        for (int n = 0; n < 2; ++n) { *(f32x4*)(HL + (size_t)(q * 2 + (fr - 14)) * 5632 + bj * 2816 + gcol + 4 * n) = acc[ai][bj][3][n];
                            if ((pm & 15) == 15 && ai == 1 && wr == 1) *(f32x4*)(out + cfg::O_CP + (size_t)((layer_ * 4 + (pm >> 4)) * 2 + (fr - 14)) * 5632 + bj * 2816 + gcol + 4 * n) = acc[ai][bj][3][n]; }
                }
            }
        }
        asm volatile("s_waitcnt lgkmcnt(0)" ::: "memory"); __builtin_amdgcn_s_barrier(); asm volatile("" ::: "memory");
        const int l1 = ((lane & 48) | ((fr - 1) & 15)) * 4, l2 = ((lane & 48) | ((fr - 2) & 15)) * 4;
#pragma unroll
        for (int ai = 0; ai < 2; ++ai) {
            int sw = 0, sa = 0; bool have = true;
            if (wr == 1) { sw = wid - 4; sa = ai; } else if (ai == 1) { sw = wid + 4; sa = 0; } else have = false;
#ifdef NO_XCHG
            have = false;
#endif
            const int rowb = pm * 256 + ai * 128 + wr * 64 + fr;
#pragma unroll
            for (int n = 0; n < 2; ++n) {
                u32x2 wpk[4];
#pragma unroll
                for (int ip = 0; ip < 2; ++ip) {
                    f32x2 hcu[4];
#pragma unroll
                    for (int bj = 1; bj >= 0; --bj) {
                        const unsigned cby = (unsigned)(bj * 2816 + gcol + 4 * n + 2 * ip) * 4u;
                        const f32x2 w0 = *(const f32x2*)((const char*)cw + cby), w1 = *(const f32x2*)((const char*)cw + (cby + 5632u * 4u)), w2 = *(const f32x2*)((const char*)cw + (cby + 2u * 5632u * 4u)), b0 = *(const f32x2*)((const char*)cb + cby);
                        f32x2 xm1 = (f32x2){0.f, 0.f};
                        if (have && fr >= 14) xm1 = *(const PG8_LAS f32x2*)((const PG8_LAS float*)(X + ((((sw * 2 + sa) * 2 + bj) * 2 + n) * 4 + fq) * 2 + (fr - 14)) + 2 * ip);
                        float t1m[2], t2m[2];
#pragma unroll
                        for (int e = 0; e < 2; ++e) { t1m[e] = EPIUP_SHF(xm1[e], l1); t2m[e] = EPIUP_SHF(xm1[e], l2); }
#pragma unroll
                        for (int m = 0; m < 4; ++m) {
                            f32x2 hc;
#pragma unroll
                            for (int e = 0; e < 2; ++e) { const float x = acc[ai][bj][m][n][2 * ip + e];
                                const float t1 = EPIUP_SHF(x, l1), t2 = EPIUP_SHF(x, l2); const float p1 = fr >= 1 ? t1 : t1m[e], p2 = fr >= 2 ? t2 : t2m[e];
                                hc[e] = b0[e] + w0[e] * p2 + w1[e] * p1 + w2[e] * x; t1m[e] = t1; t2m[e] = t2; }
                            if (bj == 1) hcu[m] = hc;
                            else { const f32x2 gg = gelu_pk(hc); const unsigned w = cvt_pk_bf16(gg.x * hcu[m].x, gg.y * hcu[m].y); if (ip == 0) wpk[m].x = w; else wpk[m].y = w; }
                        }
                        asm volatile("" ::: "memory");
                    }
                }
#pragma unroll
                for (int m = 0; m < 4; ++m) *(u32x2*)(ACT + (size_t)(rowb + 16 * m) * 2816 + gcol + 4 * n) = wpk[m];
            }
        }
#undef EPIUP_SHF
    }
};
template <class Epi, class Sched, bool ALIGN_EPI = false, bool SP2 = false>
__device__ __forceinline__ void gemm_phase(PG8_LAS unsigned char* lds, const Gemm g, const Sched& S, const Epi& E, const int wid_s  ) {
    unsigned ones_ = ~0u; asm volatile("" : "+s"(ones_) :: "memory"); const int lane_ = (int)__builtin_amdgcn_mbcnt_hi(ones_, __builtin_amdgcn_mbcnt_lo(ones_, 0u));
    const int wid = wid_s, lane = lane_, tid = wid * 64 + lane, wr = wid >> 2, wc = wid & 3, fr = lane & 15, fq = lane >> 4;
    const int K = g.K, nt = K / BK;
    unsigned voffA[2], voffB[2];
#pragma unroll
    for (int i = 0; i < 2; ++i) { int R, C; stage_rc(tid * 16 + i * 8192, R, C); const int Rb = Epi::PERM ? ((R & ~31) + perm32(R & 31)) : R;
        voffA[i] = (unsigned)(R * K + C) * 2u; voffB[i] = (unsigned)(Rb * K + C) * 2u; }
    const size_t kstep = (size_t)(BK * 2);
    const size_t hstep = (size_t)HALF * K * 2;
    const size_t tstep = 2 * hstep;
    const unsigned ldsw = (unsigned)wid * 1024u;
    const int aoff = lds_byte(wr * 64 + fr, fq * 8), boff = lds_byte(wc * 32 + fr, fq * 8);
#define PG8_SA(b, h) (((b) * 2 + (h)) * HTB)
#define PG8_SB(b, h) ((4 + (b) * 2 + (h)) * HTB)
#define PG8_STAGE(bufoff, gbase, voff) do { _Pragma("unroll") for (int _i = 0; _i < 2; ++_i) \
        __builtin_amdgcn_global_load_lds((const unsigned*)((const char*)(gbase) + (voff)[_i]), (PG8_LAS unsigned*)(lds + (bufoff) + ldsw + _i * 8192), 16, 0, 0); } while (0)
#define PG8_LDA(dst, b, h) do { _Pragma("unroll") for (int m = 0; m < 4; ++m) _Pragma("unroll") for (int k = 0; k < 2; ++k) dst[m][k] = *(const PG8_LAS bf16x8*)(lds + PG8_SA(b, h) + aoff + m * 2048 + k * 1024); } while (0)
#define PG8_LDB(dst, b, h) do { _Pragma("unroll") for (int n = 0; n < 2; ++n) _Pragma("unroll") for (int k = 0; k < 2; ++k) dst[n][k] = *(const PG8_LAS bf16x8*)(lds + PG8_SB(b, h) + boff + n * 2048 + k * 1024); } while (0)
#define PG8_MMA(ai, bj, At, Bt) do { __builtin_amdgcn_s_setprio(1); _Pragma("unroll") for (int m = 0; m < 4; ++m) _Pragma("unroll") for (int n = 0; n < 2; ++n) _Pragma("unroll") for (int k = 0; k < 2; ++k) \
        acc[ai][bj][m][n] = __builtin_amdgcn_mfma_f32_16x16x32_bf16(Bt[n][k], At[m][k], acc[ai][bj][m][n], 0, 0, 0); __builtin_amdgcn_s_setprio(0); } while (0)
#define PG8_WAIT_V(n) asm volatile("s_waitcnt vmcnt(" #n ")" ::: "memory")
#define PG8_WAIT_L(n) asm volatile("s_waitcnt lgkmcnt(" #n ")" ::: "memory")
#define PG8_BAR __builtin_amdgcn_s_barrier()
#define PG8_SCHED __builtin_amdgcn_sched_barrier(0)
    Unit cur, nxt; int ui = 0;
    if (!S.next(0, cur)) return;
    f32x4 acc[2][2][4][2];
#pragma unroll
    for (int a = 0; a < 2; ++a)
#pragma unroll
        for (int b = 0; b < 2; ++b)
#pragma unroll
            for (int m = 0; m < 4; ++m)
#pragma unroll
                for (int n = 0; n < 2; ++n) acc[a][b][m][n] = (f32x4){0.f, 0.f, 0.f, 0.f};
    bf16x8 At[4][2], B0[2][2], B1[2][2];
    const char* cA = (const char*)g.A + (size_t)cur.pm * tstep; const char* cB = (const char*)g.Bt + (size_t)cur.pn * tstep;
    S.a_ready(cur);
    if constexpr (SP2) {
        PG8_STAGE(PG8_SB(0, 0), cB, voffB); PG8_STAGE(PG8_SB(0, 1), cB + hstep, voffB); PG8_STAGE(PG8_SA(0, 0), cA, voffA); PG8_STAGE(PG8_SA(0, 1), cA + hstep, voffA);
        if (wr == 1) PG8_BAR;
        PG8_WAIT_V(2); PG8_BAR;
        PG8_STAGE(PG8_SB(1, 0), cB + kstep, voffB); PG8_STAGE(PG8_SA(1, 0), cA + kstep, voffA); PG8_STAGE(PG8_SB(1, 1), cB + hstep + kstep, voffB);
        PG8_WAIT_V(6); PG8_BAR;
    } else {
        PG8_STAGE(PG8_SB(0, 0), cB, voffB); PG8_STAGE(PG8_SA(0, 0), cA, voffA); PG8_STAGE(PG8_SB(0, 1), cB + hstep, voffB); PG8_STAGE(PG8_SA(0, 1), cA + hstep, voffA);
        if (wr == 1) PG8_BAR;
        PG8_WAIT_V(4); PG8_BAR;
        PG8_STAGE(PG8_SB(1, 0), cB + kstep, voffB); PG8_STAGE(PG8_SA(1, 0), cA + kstep, voffA); PG8_STAGE(PG8_SB(1, 1), cB + hstep + kstep, voffB);
        PG8_WAIT_V(6); PG8_BAR;
    }
    for (;;) {
        const bool has_next = S.next(ui + 1, nxt);
        const char* nA = has_next ? (const char*)g.A + (size_t)nxt.pm * tstep : cA; const char* nB = has_next ? (const char*)g.Bt + (size_t)nxt.pn * tstep : cB;
        for (int t = 0; t < nt; t += 2) {
            const bool last = (t == nt - 2);
            const char* a1 = cA + (size_t)(t + 1) * kstep;
            const char* a2 = last ? nA : cA + (size_t)(t + 2) * kstep; const char* b2 = last ? nB : cB + (size_t)(t + 2) * kstep;
            const char* a3 = a2 + kstep; const char* b3 = b2 + kstep;
            if (last && has_next) S.a_ready(nxt);
            if constexpr (SP2) {
            PG8_LDB(B0, 0, 0); PG8_LDB(B1, 0, 1); PG8_SCHED; PG8_LDA(At, 0, 0); PG8_STAGE(PG8_SA(1, 1), a1 + hstep, voffA);
            PG8_WAIT_V(8); PG8_WAIT_L(0); PG8_BAR; PG8_MMA(0, 0, At, B0); PG8_MMA(0, 1, At, B1); PG8_BAR; PG8_SCHED;
            PG8_LDA(At, 0, 1); PG8_STAGE(PG8_SB(0, 0), b2, voffB); PG8_STAGE(PG8_SB(0, 1), b2 + hstep, voffB); PG8_STAGE(PG8_SA(0, 0), a2, voffA);
            PG8_WAIT_V(8); PG8_WAIT_L(0); PG8_BAR; PG8_MMA(1, 0, At, B0); PG8_MMA(1, 1, At, B1); PG8_BAR; PG8_SCHED;
            PG8_LDB(B0, 1, 0); PG8_LDB(B1, 1, 1); PG8_SCHED; PG8_LDA(At, 1, 0); PG8_STAGE(PG8_SA(0, 1), a2 + hstep, voffA);
            PG8_WAIT_V(8); PG8_WAIT_L(0); PG8_BAR; PG8_MMA(0, 0, At, B0); PG8_MMA(0, 1, At, B1); PG8_BAR; PG8_SCHED;
            PG8_LDA(At, 1, 1); PG8_STAGE(PG8_SB(1, 0), b3, voffB); PG8_STAGE(PG8_SB(1, 1), b3 + hstep, voffB); PG8_STAGE(PG8_SA(1, 0), a3, voffA);
            PG8_WAIT_V(8); PG8_WAIT_L(0); PG8_BAR; PG8_MMA(1, 0, At, B0); PG8_MMA(1, 1, At, B1); PG8_BAR; PG8_SCHED;
            } else {
            PG8_LDB(B0, 0, 0); PG8_SCHED; PG8_LDA(At, 0, 0); PG8_STAGE(PG8_SA(1, 1), a1 + hstep, voffA);
            PG8_WAIT_L(8); PG8_BAR; PG8_WAIT_L(0); PG8_MMA(0, 0, At, B0); PG8_BAR; PG8_SCHED;
            PG8_LDB(B1, 0, 1); PG8_STAGE(PG8_SB(0, 0), b2, voffB);
            PG8_BAR; PG8_WAIT_L(0); PG8_MMA(0, 1, At, B1); PG8_BAR;
            PG8_LDA(At, 0, 1); PG8_STAGE(PG8_SA(0, 0), a2, voffA);
            PG8_BAR; PG8_WAIT_L(0); PG8_MMA(1, 0, At, B0); PG8_BAR; PG8_SCHED;
            PG8_STAGE(PG8_SB(0, 1), b2 + hstep, voffB);
            PG8_WAIT_V(6); PG8_BAR; PG8_MMA(1, 1, At, B1); PG8_BAR;
            PG8_LDB(B0, 1, 0); PG8_SCHED; PG8_LDA(At, 1, 0); PG8_STAGE(PG8_SA(0, 1), a2 + hstep, voffA);
            PG8_WAIT_L(8); PG8_BAR; PG8_WAIT_L(0); PG8_MMA(0, 0, At, B0); PG8_BAR; PG8_SCHED;
            PG8_LDB(B1, 1, 1); PG8_STAGE(PG8_SB(1, 0), b3, voffB);
            PG8_BAR; PG8_WAIT_L(0); PG8_MMA(0, 1, At, B1); PG8_BAR;
            PG8_LDA(At, 1, 1); PG8_STAGE(PG8_SA(1, 0), a3, voffA);
            PG8_BAR; PG8_WAIT_L(0); PG8_MMA(1, 0, At, B0); PG8_BAR; PG8_SCHED;
            PG8_STAGE(PG8_SB(1, 1), b3 + hstep, voffB);
            PG8_WAIT_V(6); PG8_BAR; PG8_MMA(1, 1, At, B1); PG8_BAR;
            }
        }
        if constexpr (ALIGN_EPI) { if (wr == 0) PG8_BAR; }
        if constexpr (!Epi::AFTER_DRAIN) { unsigned o2_ = ~0u; asm volatile("" : "+s"(o2_) :: "memory"); const int ln = (int)__builtin_amdgcn_mbcnt_hi(o2_, __builtin_amdgcn_mbcnt_lo(o2_, 0u)); E(acc, cur, wr, wc, ln & 15, ln >> 4); S.done(cur); }
        if (!has_next) break;
#pragma unroll
        for (int a = 0; a < 2; ++a)
#pragma unroll
            for (int b = 0; b < 2; ++b)
#pragma unroll
                for (int m = 0; m < 4; ++m)
#pragma unroll
                    for (int n = 0; n < 2; ++n) acc[a][b][m][n] = (f32x4){0.f, 0.f, 0.f, 0.f};
        cur = nxt; cA = nA; cB = nB; ++ui;
        if constexpr (ALIGN_EPI) { if (wr == 1) PG8_BAR; }
    }
    PG8_WAIT_V(0);
    if constexpr (!ALIGN_EPI) { if (wr == 0) PG8_BAR; }
    PG8_BAR;
    if constexpr (Epi::AFTER_DRAIN) { E.fused(acc, cur, wr, wc, fr, fq, lds, wid, lane); S.done(cur); }
#undef PG8_SA
#undef PG8_SB
#undef PG8_STAGE
#undef PG8_LDA
#undef PG8_LDB
#undef PG8_MMA
#undef PG8_WAIT_V
#undef PG8_WAIT_L
#undef PG8_BAR
#undef PG8_SCHED
}
}
#define GAS __attribute__((address_space(1)))
#define LAS __attribute__((address_space(3)))
typedef unsigned short bf16;
typedef unsigned v4u __attribute__((ext_vector_type(4)));
typedef float f32x4 __attribute__((ext_vector_type(4)));
typedef short bf16x8 __attribute__((ext_vector_type(8)));
typedef GAS unsigned gu32;
typedef GAS unsigned long long gu64;
#define RLX_AGENT __ATOMIC_RELAXED, __HIP_MEMORY_SCOPE_AGENT
#define LDS_WAIT() asm volatile("s_waitcnt lgkmcnt(0)" ::: "memory")
#define VM_WAIT() asm volatile("s_waitcnt vmcnt(0)" ::: "memory")
__device__ __forceinline__ unsigned long long rt() { return __builtin_amdgcn_s_memrealtime(); }
__device__ __forceinline__ unsigned f2bf(float f) { unsigned u = __builtin_bit_cast(unsigned, f); return (u + 0x7fffu + ((u >> 16) & 1u)) >> 16; }
__device__ __forceinline__ unsigned pk2(float lo, float hi) { return f2bf(lo) | (f2bf(hi) << 16); }

#define XB_TMO      128
#define XB_XCNT(j)  (256  + 64 * (j))
#define XB_XSUB(j)  (1280 + 64 * (j))
#define XB_XGEN(j)  (2304 + 64 * (j))
#define XB_TOP      3328
#define XB_TOPGEN   3392
#define XCD_BAR_WORDS 3456
#define XB_SPIN_CAP (1u << 18)

__device__ __forceinline__ unsigned xb_ld(unsigned* p)              { return __hip_atomic_load(p, __ATOMIC_RELAXED, __HIP_MEMORY_SCOPE_AGENT); }
__device__ __forceinline__ unsigned xb_add(unsigned* p, unsigned v) { return __hip_atomic_fetch_add(p, v, __ATOMIC_RELAXED, __HIP_MEMORY_SCOPE_AGENT); }
__device__ __forceinline__ unsigned xb_xcc_id() { return (unsigned)__builtin_amdgcn_s_getreg((3 << 11) | 20) & 0xFu; }
#define XB_SPIN(cond, bar) do { unsigned _sp = 0; while (cond) { __builtin_amdgcn_s_sleep(1); \
    if ((++_sp & 255u) == 0u) { if (xb_ld(&(bar)[XB_TMO])) break; if (_sp > XB_SPIN_CAP) { atomicAdd(&(bar)[XB_TMO], 1u); break; } } } } while (0)

struct XcdBarrier {
    unsigned* bar; unsigned x;
    volatile LAS unsigned* st;
};

__device__ __forceinline__ XcdBarrier xcd_barrier_post(unsigned* bar, volatile LAS unsigned* st, const bool leader) {
    XcdBarrier b; b.bar = bar; b.x = xb_xcc_id(); b.st = st;
    if (leader) (void)xb_add(&bar[XB_XCNT(b.x)], 1u);
    return b;
}
__device__ __forceinline__ void xcd_barrier_complete(unsigned* bar, unsigned x, unsigned& nloc, unsigned& nx) {
    const unsigned G = gridDim.x * gridDim.y * gridDim.z;
    unsigned sum, cnt, mine, sp = 0u;
    for (;;) {
        sum = 0u; cnt = 0u; mine = 0u;
#pragma unroll
        for (unsigned j = 0; j < 16; ++j) { const unsigned c = xb_ld(&bar[XB_XCNT(j)]); sum += c; cnt += (c > 0u) ? 1u : 0u; mine = (j == x) ? c : mine; }
        if (sum == G) break;
        __builtin_amdgcn_s_sleep(1);
        if ((++sp & 255u) == 0u) { if (xb_ld(&bar[XB_TMO])) break; if (sp > XB_SPIN_CAP) { atomicAdd(&bar[XB_TMO], 1u); break; } }
    }
    nloc = mine > 0u ? mine : 1u; nx = cnt > 0u ? cnt : 1u;
}

__device__ __forceinline__ void xcd_barrier(const XcdBarrier& b, const bool leader  ) {
    asm volatile("s_waitcnt vmcnt(0)" ::: "memory");
    __syncthreads();
    if (leader) {
        unsigned* bar = b.bar;
        __builtin_amdgcn_s_waitcnt(0);
        unsigned nloc = b.st[0], nx = b.st[1];
        if (nloc == 0u) { xcd_barrier_complete(bar, b.x, nloc, nx); b.st[0] = nloc; b.st[1] = nx; }
        const unsigned old = xb_add(&bar[XB_XSUB(b.x)], 1u);
        const unsigned gen = old / nloc;
        if (old + 1u == (gen + 1u) * nloc) {
            __builtin_amdgcn_fence(__ATOMIC_RELEASE, "agent");
            asm volatile("s_waitcnt vmcnt(0)" ::: "memory");
            const unsigned og = xb_add(&bar[XB_TOP], 1u);
            const unsigned tg = og / nx;
            if (og + 1u == (tg + 1u) * nx) xb_add(&bar[XB_TOPGEN], 1u);
            else XB_SPIN(xb_ld(&bar[XB_TOPGEN]) == tg, bar);
            __builtin_amdgcn_fence(__ATOMIC_ACQUIRE, "agent");
            xb_add(&bar[XB_XGEN(b.x)], 1u);
            asm volatile("s_waitcnt vmcnt(0)" ::: "memory");
        } else {
            XB_SPIN(xb_ld(&bar[XB_XGEN(b.x)]) == gen, bar);
            __builtin_amdgcn_fence(__ATOMIC_ACQUIRE, "agent");
            asm volatile("s_waitcnt vmcnt(0)" ::: "memory");
        }
    }
    __syncthreads();
}

constexpr int NWAVES = 8;
constexpr size_t MiB = 1u << 20;
constexpr size_t WS_CTL = 0, CTL_ZERO_BYTES = 1 * MiB;
constexpr size_t WS_ROPE = 1 * MiB;
constexpr size_t WS_W = 4 * MiB, W_LAYER = 22 * MiB;
constexpr size_t W_IN = 0, W_OUT = 3670016, W_UP = 5767168, W_DOWN = 17301504;
constexpr size_t WS_XB = 48 * MiB;
constexpr size_t WS_HF = 208 * MiB, WS_HL = 220 * MiB;
constexpr size_t WS_MIX = 90 * MiB;
constexpr size_t WS_ZV = 124 * MiB;
constexpr size_t WS_KB = 141 * MiB, WS_VB = 146 * MiB;
constexpr size_t WS_ACT = 90 * MiB;
constexpr size_t WS_UPS = 184 * MiB;
constexpr size_t WS_END = 232 * MiB;
constexpr int CW_BAR = 4096;
constexpr int RING_OFF = 0, RING_BYTES = 131072;
constexpr int XCH_OFF = RING_BYTES;
constexpr int LDSCTL_OFF = RING_BYTES + 8192, MISC_OFF = LDSCTL_OFF + 320;
constexpr int LDS_BYTES = 147456;
static_assert(MISC_OFF + 128 <= LDS_BYTES, "LDS map");

struct Frame {
    LAS unsigned char* lds; volatile LAS unsigned* MISC; gu32* ctl;
    int tid, lane, wave, vcu, G;
};
struct Args { const float* in[20]; float* out; unsigned char* ws; float inv_freq[32]; };
typedef const __attribute__((address_space(4))) Args* ArgsP;

__device__ __forceinline__ float bf2f(unsigned short b) { return __builtin_bit_cast(float, ((unsigned)b) << 16); }
__device__ __forceinline__ float bflo(unsigned w) { return __builtin_bit_cast(float, w << 16); }
__device__ __forceinline__ float bfhi(unsigned w) { return __builtin_bit_cast(float, w & 0xffff0000u); }
__device__ __forceinline__ float wave_sum(float v) {
#pragma unroll
    for (int o = 1; o < 64; o <<= 1) v += __shfl_xor(v, o);
    return v;
}
__device__ __forceinline__ float gelu1(float v) { const pg8::f32x2 r = pg8::gelu_pk((pg8::f32x2){v, v}); return r.x; }
__device__ __forceinline__ float fexp(float x) { return __builtin_amdgcn_exp2f(x * 1.4426950408889634f); }

__device__ __forceinline__ int dst_row(int mode, int n0, int n) {
    if (mode == 0) return n0 + n;
    const int slot = 16 * ((n >> 2) & 1) + 4 * (n >> 3) + (n & 3);
    if (mode == 1) return (n0 & ~255) + 128 * ((n0 >> 5) & 1) + 32 * ((n0 >> 6) & 3) + slot;
    const int c = n0 >= cfg::FF ? n0 - cfg::FF : n0;
    return 256 * (c >> 7) + (n0 >= cfg::FF ? 128 : 0) + 32 * ((c >> 5) & 3) + slot;
}
__device__ __forceinline__ void p0_transpose_item(const float* W, int K, int N, bf16* WT, int mode, LAS float* scr, int item, int lane) {
    const int nblk = N / 32, kb = item / nblk, nb = item % nblk, k0 = 64 * kb, n0 = 32 * nb;
#pragma unroll 8
    for (int i = 0; i < 32; ++i) { const int kk = 2 * i + (lane >> 5); scr[kk * 33 + (lane & 31)] = W[(size_t)(k0 + kk) * N + n0 + (lane & 31)]; }
    LDS_WAIT(); asm volatile("" ::: "memory");
    const int c = lane & 7;
#pragma unroll
    for (int j = 0; j < 4; ++j) { const int n = (lane >> 3) + 8 * j; const LAS float* s = scr + (8 * c) * 33 + n;
        v4u o; o.x = pk2(s[0 * 33], s[1 * 33]); o.y = pk2(s[2 * 33], s[3 * 33]); o.z = pk2(s[4 * 33], s[5 * 33]); o.w = pk2(s[6 * 33], s[7 * 33]);
        *(GAS v4u*)(WT + (size_t)dst_row(mode, n0, n) * K + k0 + 8 * c) = o; }
    LDS_WAIT(); asm volatile("" ::: "memory");
}
__device__ __forceinline__ void sincos_d(float ang, float& c, float& s) {
    const double x = (double)ang, k = __builtin_rint(x * 0.63661977236758134308);
    double r = __builtin_fma(-k, 1.57079632679489655800e+00, x); r = __builtin_fma(-k, 6.12323399573676603587e-17, r);
    const double r2 = r * r;
    const double sp = r * (1.0 + r2 * (-1.0 / 6 + r2 * (1.0 / 120 + r2 * (-1.0 / 5040 + r2 * (1.0 / 362880 + r2 * (-1.0 / 39916800))))));
    const double cp = 1.0 + r2 * (-0.5 + r2 * (1.0 / 24 + r2 * (-1.0 / 720 + r2 * (1.0 / 40320 + r2 * (-1.0 / 3628800 + r2 * (1.0 / 479001600))))));
    const int q = (int)k & 3;
    const double cc = (q == 0) ? cp : (q == 1) ? -sp : (q == 2) ? -cp : sp, ss = (q == 0) ? sp : (q == 1) ? cp : (q == 2) ? -sp : -cp;
    c = (float)cc; s = (float)ss;
}
__device__ __forceinline__ void p0_prologue(Frame& F, ArgsP a) {
    LAS float* scr = (LAS float*)(F.lds + RING_OFF + F.wave * 16384);
    const int gw = F.vcu * NWAVES + F.wave, NGW = F.G * NWAVES;
    bf16* wbase = (bf16*)(a->ws + WS_W);
    constexpr int I_IN = (cfg::D / 64) * (cfg::NIN / 32), I_OUT = (cfg::D / 64) * (cfg::D / 32), I_UP = (cfg::D / 64) * (cfg::NUP / 32), I_DN = (cfg::FF / 64) * (cfg::D / 32);
    constexpr int I_L = I_IN + I_OUT + I_UP + I_DN;
#pragma unroll 1
    for (int it = gw; it < 2 * I_L; it += NGW) {
        const int l = it / I_L; int r = it % I_L; bf16* wl = (bf16*)((unsigned char*)wbase + (size_t)l * W_LAYER);
        if (r < I_IN) { p0_transpose_item(a->in[5] + (size_t)l * cfg::D * cfg::NIN, cfg::D, cfg::NIN, (bf16*)((unsigned char*)wl + W_IN), 1, scr, r, F.lane); continue; } r -= I_IN;
        if (r < I_OUT) { p0_transpose_item(a->in[11] + (size_t)l * cfg::D * cfg::D, cfg::D, cfg::D, (bf16*)((unsigned char*)wl + W_OUT), 0, scr, r, F.lane); continue; } r -= I_OUT;
        if (r < I_UP) { p0_transpose_item(a->in[14] + (size_t)l * cfg::D * cfg::NUP, cfg::D, cfg::NUP, (bf16*)((unsigned char*)wl + W_UP), 2, scr, r, F.lane); continue; } r -= I_UP;
        p0_transpose_item(a->in[17] + (size_t)l * cfg::FF * cfg::D, cfg::FF, cfg::D, (bf16*)((unsigned char*)wl + W_DOWN), 0, scr, r, F.lane);
    }
    bf16* XB = (bf16*)(a->ws + WS_XB);
#pragma unroll 1
    for (int m = gw; m < cfg::M; m += NGW) {
        const float* xr = m < cfg::MP ? a->in[0] + (size_t)m * 1024 : a->in[1] + (size_t)(m - cfg::MP) * 1024;
        const GAS f32x4* x4 = (const GAS f32x4*)xr + F.lane; GAS unsigned long long* o8 = (GAS unsigned long long*)(XB + (size_t)m * 1024) + F.lane;
#pragma unroll
        for (int j = 0; j < 4; ++j) { const f32x4 v = x4[64 * j]; o8[64 * j] = (unsigned long long)pk2(v.x, v.y) | ((unsigned long long)pk2(v.z, v.w) << 32); }
    }
    {
        float invf = 0.f;
#pragma unroll
        for (int i = 0; i < 32; ++i) if ((F.tid & 31) == i) invf = a->inv_freq[i];
        float* tab = (float*)(a->ws + WS_ROPE);
#pragma unroll 1
        for (int e = (F.vcu * 512 + F.tid); e < 4104 * 32; e += F.G * 512) {
            const int p = e >> 5; const float pos = (float)(p < 4096 ? p : 16384 + (p - 4096)); float c, s; sincos_d(pos * invf, c, s);
            tab[2 * e] = c; tab[2 * e + 1] = s; }
    }
#pragma unroll 2
    for (int e = F.vcu * 512 + F.tid; e < 2 * 256 * 3840; e += F.G * 512) {
        const int kv = e / (256 * 3840), r = e % (256 * 3840), lb = r / 3840, q = r % 3840;
        const float* src = kv ? a->in[3] : a->in[2]; const f32x4 v = *((const GAS f32x4*)(src + (size_t)lb * 16384 + 1024) + q);
        *((GAS f32x4*)(a->out + (kv ? cfg::O_VS : cfg::O_KS) + (size_t)lb * 16384) + q) = v; }
}

__device__ __forceinline__ void ln_rows(Frame& F, float* Y, bf16* XB, const float* g, const float* b) {
    const int gw = F.vcu * NWAVES + F.wave, NGW = F.G * NWAVES;
    f32x4 gv[4], bv[4];
#pragma unroll
    for (int j = 0; j < 4; ++j) { gv[j] = *((const GAS f32x4*)g + F.lane + 64 * j); bv[j] = *((const GAS f32x4*)b + F.lane + 64 * j); }
#pragma unroll 1
    for (int m = gw; m < cfg::M; m += NGW) {
        GAS f32x4* yr = (GAS f32x4*)(Y + (size_t)m * 1024) + F.lane;
        f32x4 v[4]; float s = 0.f;
#pragma unroll
        for (int j = 0; j < 4; ++j) { v[j] = yr[64 * j]; s += (v[j].x + v[j].y) + (v[j].z + v[j].w); }
        const float mean = wave_sum(s) * (1.f / 1024.f); float s2 = 0.f;
#pragma unroll
        for (int j = 0; j < 4; ++j) { v[j] = v[j] - mean; s2 += (v[j].x * v[j].x + v[j].y * v[j].y) + (v[j].z * v[j].z + v[j].w * v[j].w); }
        const float rstd = 1.f / sqrtf(wave_sum(s2) * (1.f / 1024.f) + cfg::LN_EPS);
        GAS unsigned long long* o8 = (GAS unsigned long long*)(XB + (size_t)m * 1024) + F.lane;
#pragma unroll
        for (int j = 0; j < 4; ++j) { const f32x4 o = v[j] * rstd * gv[j] + bv[j]; yr[64 * j] = o; o8[64 * j] = (unsigned long long)pk2(o.x, o.y) | ((unsigned long long)pk2(o.z, o.w) << 32); }
    }
}

__device__ __forceinline__ void p2_gmlp_prompt(Frame& F, ArgsP a, int layer) {
    LAS float* Wl = (LAS float*)(F.lds);
    LAS float* Zl = (LAS float*)(F.lds + 66560);
    bf16* MIX = (bf16*)(a->ws + WS_MIX); const bf16* ZV = (const bf16*)(a->ws + WS_ZV);
    const float* Wsp = a->in[8] + (size_t)layer * 8 * 128 * 128; const float* bsp = a->in[9] + (size_t)layer * 8 * 128;
#pragma unroll 1
    for (int item = F.vcu; item < 1024; item += F.G) {
        const int h = item & 7, bc = item >> 3, row0 = (bc >> 5) * 4096 + (bc & 31) * 128;
        for (int k = 0; k < 32; ++k) { const int idx = F.tid + 512 * k, t = idx >> 7, s = idx & 127; Wl[t * 129 + s] = Wsp[(size_t)(h * 128 + t) * 128 + s]; }
#pragma unroll
        for (int k = 0; k < 2; ++k) { const int idx = F.tid + 512 * k, s = idx >> 3, c8 = idx & 7; const v4u w = *(const GAS v4u*)(ZV + (size_t)(row0 + s) * 512 + 64 * h + 8 * c8);
            LAS float* z = Zl + s * 64 + 8 * c8; z[0] = bflo(w.x); z[1] = bfhi(w.x); z[2] = bflo(w.y); z[3] = bfhi(w.y); z[4] = bflo(w.z); z[5] = bfhi(w.z); z[6] = bflo(w.w); z[7] = bfhi(w.w); }
        __syncthreads();
        const int t = F.tid >> 2, cg = F.tid & 3, tmax = F.wave * 16 + 15;
        float acc[16];
#pragma unroll
        for (int j = 0; j < 16; ++j) acc[j] = 0.f;
#pragma unroll 2
        for (int s = 0; s <= tmax; ++s) { const float w = (s <= t) ? Wl[t * 129 + s] : 0.f; const LAS f32x4* z = (const LAS f32x4*)(Zl + s * 64 + 16 * cg);
#pragma unroll
            for (int j = 0; j < 4; ++j) { const f32x4 zz = z[j]; acc[4 * j] += w * zz.x; acc[4 * j + 1] += w * zz.y; acc[4 * j + 2] += w * zz.z; acc[4 * j + 3] += w * zz.w; } }
        const float bsv = bsp[h * 128 + t];
        GAS v4u* mp = (GAS v4u*)(MIX + (size_t)(row0 + t) * 1024 + 64 * h + 16 * cg);
#pragma unroll
        for (int j = 0; j < 2; ++j) { const v4u zu = mp[j]; v4u o;
            o.x = pk2(bflo(zu.x) * (acc[8 * j + 0] + bsv), bfhi(zu.x) * (acc[8 * j + 1] + bsv)); o.y = pk2(bflo(zu.y) * (acc[8 * j + 2] + bsv), bfhi(zu.y) * (acc[8 * j + 3] + bsv));
            o.z = pk2(bflo(zu.z) * (acc[8 * j + 4] + bsv), bfhi(zu.z) * (acc[8 * j + 5] + bsv)); o.w = pk2(bflo(zu.w) * (acc[8 * j + 6] + bsv), bfhi(zu.w) * (acc[8 * j + 7] + bsv));
            mp[j] = o; }
        __syncthreads();
    }
}
__device__ __forceinline__ void p2_attn_prompt(Frame& F, ArgsP a, int layer) {
    LAS float* Kl = (LAS float*)F.lds; LAS float* Vl = Kl + 256 * 68;
    bf16* MIX = (bf16*)(a->ws + WS_MIX); const bf16* KB = (const bf16*)(a->ws + WS_KB); const bf16* VB = (const bf16*)(a->ws + WS_VB);
    const float* sinks = a->in[10] + layer * 8;
#pragma unroll 1
    for (int item = F.vcu; item < 256; item += F.G) {
        const int kvh = item & 1, nb = (item >> 1) & 31, b = item >> 6, rowq0 = b * 4096 + nb * 128;
#pragma unroll
        for (int k = 0; k < 4; ++k) { const int idx = F.tid + 512 * k, i = idx >> 3, c8 = idx & 7; const bool valid = (nb > 0) || (i >= 128);
            v4u kk = (v4u){0u, 0u, 0u, 0u}, vv = kk;
            if (valid) { const size_t off = (size_t)(rowq0 - 128 + i) * 128 + 64 * kvh + 8 * c8; kk = *(const GAS v4u*)(KB + off); vv = *(const GAS v4u*)(VB + off); }
            LAS float* kz = Kl + i * 68 + 8 * c8; LAS float* vz = Vl + i * 68 + 8 * c8;
            kz[0] = bflo(kk.x); kz[1] = bfhi(kk.x); kz[2] = bflo(kk.y); kz[3] = bfhi(kk.y); kz[4] = bflo(kk.z); kz[5] = bfhi(kk.z); kz[6] = bflo(kk.w); kz[7] = bfhi(kk.w);
            vz[0] = bflo(vv.x); vz[1] = bfhi(vv.x); vz[2] = bflo(vv.y); vz[3] = bfhi(vv.y); vz[4] = bflo(vv.z); vz[5] = bfhi(vv.z); vz[6] = bflo(vv.w); vz[7] = bfhi(vv.w); }
        __syncthreads();
        const int ql = F.tid & 127, g = F.tid >> 7, head = 4 * kvh + g;
        GAS v4u* qp = (GAS v4u*)(MIX + (size_t)(rowq0 + ql) * 1024 + 512 + 64 * head);
        unsigned qk[32]; float acc[64];
#pragma unroll
        for (int j = 0; j < 8; ++j) { const v4u w = qp[j]; qk[4 * j] = w.x; qk[4 * j + 1] = w.y; qk[4 * j + 2] = w.z; qk[4 * j + 3] = w.w; }
#pragma unroll
        for (int d = 0; d < 64; ++d) acc[d] = 0.f;
        float mrun = sinks[head], lrun = 1.f;
        const int kmin = (nb == 0) ? 128 : 0;
#pragma unroll 1
        for (int j = 0; j < 128; j += 2) {
            const int kb0 = ql + 1 + j, kb1 = kb0 + 1;
            const LAS f32x4* k0 = (const LAS f32x4*)(Kl + kb0 * 68); const LAS f32x4* k1 = (const LAS f32x4*)(Kl + kb1 * 68);
            float s0 = 0.f, s1 = 0.f;
#pragma unroll
            for (int d4 = 0; d4 < 16; ++d4) { const f32x4 x0 = k0[d4], x1 = k1[d4];
                const float q0 = bflo(qk[2 * d4]), q1 = bfhi(qk[2 * d4]), q2 = bflo(qk[2 * d4 + 1]), q3 = bfhi(qk[2 * d4 + 1]);
                s0 += q0 * x0.x + q1 * x0.y + q2 * x0.z + q3 * x0.w;
                s1 += q0 * x1.x + q1 * x1.y + q2 * x1.z + q3 * x1.w; }
            if (kb0 < kmin) s0 = -1e30f;
            if (kb1 < kmin) s1 = -1e30f;
            const float mn = fmaxf(mrun, fmaxf(s0, s1)), al = fexp(mrun - mn), p0 = fexp(s0 - mn), p1 = fexp(s1 - mn);
            lrun = lrun * al + p0 + p1; mrun = mn;
            const LAS f32x4* v0 = (const LAS f32x4*)(Vl + kb0 * 68); const LAS f32x4* v1 = (const LAS f32x4*)(Vl + kb1 * 68);
#pragma unroll
            for (int d4 = 0; d4 < 16; ++d4) { const f32x4 x0 = v0[d4], x1 = v1[d4];
                acc[4 * d4] = acc[4 * d4] * al + p0 * x0.x + p1 * x1.x; acc[4 * d4 + 1] = acc[4 * d4 + 1] * al + p0 * x0.y + p1 * x1.y;
                acc[4 * d4 + 2] = acc[4 * d4 + 2] * al + p0 * x0.z + p1 * x1.z; acc[4 * d4 + 3] = acc[4 * d4 + 3] * al + p0 * x0.w + p1 * x1.w; }
        }
        const float inv = 1.f / lrun;
#pragma unroll
        for (int j = 0; j < 8; ++j) { v4u o; o.x = pk2(acc[8 * j] * inv, acc[8 * j + 1] * inv); o.y = pk2(acc[8 * j + 2] * inv, acc[8 * j + 3] * inv);
            o.z = pk2(acc[8 * j + 4] * inv, acc[8 * j + 5] * inv); o.w = pk2(acc[8 * j + 6] * inv, acc[8 * j + 7] * inv); qp[j] = o; }
        __syncthreads();
    }
}
__device__ __forceinline__ void p2_sample(Frame& F, ArgsP a, int layer) {
    LAS float* Ks = (LAS float*)F.lds; LAS float* Vs = Ks + 136 * 68; LAS float* Ql = Vs + 136 * 68; LAS float* Sl = Ql + 32 * 64;
    bf16* MIX = (bf16*)(a->ws + WS_MIX); const bf16* ZV = (const bf16*)(a->ws + WS_ZV);
    const float* Wsp = a->in[8] + (size_t)layer * 8 * 128 * 128; const float* bsp = a->in[9] + (size_t)layer * 8 * 128; const float* sinks = a->in[10] + layer * 8;
#pragma unroll 1
    for (int item = F.vcu; item < 256; item += F.G) {
        const int kvh = item & 1, b = item >> 1, srow0 = cfg::MP + b * 8, lb = layer * 128 + b;
        for (int idx = F.tid; idx < 136 * 16; idx += 512) { const int j = idx >> 4, d4 = idx & 15; f32x4 kk, vv;
            if (j < 128) { const size_t off = ((size_t)(lb * 128 + j) * 2 + kvh) * 64 + 4 * d4; kk = *(const GAS f32x4*)(a->in[2] + off); vv = *(const GAS f32x4*)(a->in[3] + off); }
            else { const size_t off = ((size_t)(lb * 128 + 120 + (j - 128)) * 2 + kvh) * 64 + 4 * d4; kk = *(const GAS f32x4*)(a->out + cfg::O_KS + off); vv = *(const GAS f32x4*)(a->out + cfg::O_VS + off); }
            *(LAS f32x4*)(Ks + j * 68 + 4 * d4) = kk; *(LAS f32x4*)(Vs + j * 68 + 4 * d4) = vv; }
        for (int idx = F.tid; idx < 32 * 64; idx += 512) { const int p = idx >> 6, d = idx & 63, t = p >> 2, g = p & 3; Ql[idx] = bf2f(MIX[(size_t)(srow0 + t) * 1024 + 512 + 64 * (4 * kvh + g) + d]); }
        __syncthreads();
        for (int idx = F.tid; idx < 32 * 136; idx += 512) { const int p = idx / 136, j = idx % 136, t = p >> 2; const bool valid = j < 128 ? (j >= t + 1) : (j - 128 <= t);
            float s = 0.f; const LAS f32x4* kr = (const LAS f32x4*)(Ks + j * 68); const LAS f32x4* qr = (const LAS f32x4*)(Ql + p * 64);
#pragma unroll
            for (int d4 = 0; d4 < 16; ++d4) { const f32x4 x = kr[d4], q = qr[d4]; s += q.x * x.x + q.y * x.y + q.z * x.z + q.w * x.w; }
            Sl[p * 137 + j] = valid ? s : -1e30f; }
        __syncthreads();
        { const int p = F.tid >> 4, sub = F.tid & 15, g = p & 3; const float sink = sinks[4 * kvh + g]; float mx = sink;
            for (int j = sub; j < 136; j += 16) mx = fmaxf(mx, Sl[p * 137 + j]);
#pragma unroll
            for (int o = 1; o < 16; o <<= 1) mx = fmaxf(mx, __shfl_xor(mx, o));
            float sum = 0.f;
            for (int j = sub; j < 136; j += 16) { const float e = fexp(Sl[p * 137 + j] - mx); Sl[p * 137 + j] = e; sum += e; }
#pragma unroll
            for (int o = 1; o < 16; o <<= 1) sum += __shfl_xor(sum, o);
            const float inv = 1.f / (sum + fexp(sink - mx));
            for (int j = sub; j < 136; j += 16) Sl[p * 137 + j] *= inv; }
        __syncthreads();
        { const int p = F.tid >> 4, d4 = F.tid & 15, t = p >> 2, g = p & 3; f32x4 o = (f32x4){0.f, 0.f, 0.f, 0.f};
            for (int j = 0; j < 136; ++j) { const float pj = Sl[p * 137 + j]; const f32x4 v = *(const LAS f32x4*)(Vs + j * 68 + 4 * d4); o = o + v * pj; }
            unsigned long long w = (unsigned long long)pk2(o.x, o.y) | ((unsigned long long)pk2(o.z, o.w) << 32);
            *(GAS unsigned long long*)(MIX + (size_t)(srow0 + t) * 1024 + 512 + 64 * (4 * kvh + g) + 4 * d4) = w; }
        { const int t = F.tid >> 6, hh = (F.tid >> 4) & 3, c4 = (F.tid & 15) * 4, h = 4 * kvh + hh; f32x4 f = (f32x4){0.f, 0.f, 0.f, 0.f};
            for (int s = 0; s <= t; ++s) { const float w = Wsp[(size_t)(h * 128 + t) * 128 + s]; const unsigned long long z = *(const GAS unsigned long long*)(ZV + (size_t)(srow0 + s) * 512 + 64 * h + c4);
                f.x += w * bflo((unsigned)z); f.y += w * bfhi((unsigned)z); f.z += w * bflo((unsigned)(z >> 32)); f.w += w * bfhi((unsigned)(z >> 32)); }
            const float bsv = bsp[h * 128 + t]; GAS unsigned long long* mp = (GAS unsigned long long*)(MIX + (size_t)(srow0 + t) * 1024 + 64 * h + c4); const unsigned long long zu = *mp;
            *mp = (unsigned long long)pk2(bflo((unsigned)zu) * (f.x + bsv), bfhi((unsigned)zu) * (f.y + bsv)) | ((unsigned long long)pk2(bflo((unsigned)(zu >> 32)) * (f.z + bsv), bfhi((unsigned)(zu >> 32)) * (f.w + bsv)) << 32); }
        __syncthreads();
    }
}
__device__ __forceinline__ void p4_fixup(Frame& F, ArgsP a, int layer) {
    const float* HF = (const float*)(a->ws + WS_HF); const float* HL = (const float*)(a->ws + WS_HL); bf16* ACT = (bf16*)(a->ws + WS_ACT);
    const float* cw = a->in[15] + (size_t)layer * 3 * cfg::NUP; const float* cb = a->in[16] + (size_t)layer * cfg::NUP;
#pragma unroll 1
    for (int e = F.vcu * 512 + F.tid; e < 256 * cfg::FF; e += F.G * 512) {
        const int q = e / cfg::FF, c = e % cfg::FF; if ((q & 63) == 0) continue;
        float hcv[2][2];
#pragma unroll
        for (int half = 0; half < 2; ++half) { const int col = half * cfg::FF + c;
            const float um2 = HL[(size_t)((q - 1) * 2) * 5632 + col], um1 = HL[(size_t)((q - 1) * 2 + 1) * 5632 + col], u0 = HF[(size_t)(q * 2) * 5632 + col], u1 = HF[(size_t)(q * 2 + 1) * 5632 + col];
            const float w0 = cw[col], w1 = cw[5632 + col], w2 = cw[2 * 5632 + col], b0 = cb[col];
            hcv[half][0] = b0 + w0 * um2 + w1 * um1 + w2 * u0; hcv[half][1] = b0 + w0 * um1 + w1 * u0 + w2 * u1; }
        ACT[(size_t)(q * 64) * cfg::FF + c] = (bf16)f2bf(gelu1(hcv[0][0]) * hcv[1][0]);
        ACT[(size_t)(q * 64 + 1) * cfg::FF + c] = (bf16)f2bf(gelu1(hcv[0][1]) * hcv[1][1]);
    }
    const float* UPS = (const float*)(a->ws + WS_UPS); const float* cconv = a->in[4] + (size_t)layer * 128 * 2 * cfg::NUP;
#pragma unroll 1
    for (int e = F.vcu * 512 + F.tid; e < cfg::MS * cfg::FF; e += F.G * 512) {
        const int s = e / cfg::FF, c = e % cfg::FF, b = s >> 3, t = s & 7; float hcv[2];
#pragma unroll
        for (int half = 0; half < 2; ++half) { const int col = half * cfg::FF + c;
            const float u0 = UPS[(size_t)s * 5632 + col];
            const float um1 = t >= 1 ? UPS[(size_t)(s - 1) * 5632 + col] : cconv[(size_t)(b * 2 + 1) * 5632 + col];
            const float um2 = t >= 2 ? UPS[(size_t)(s - 2) * 5632 + col] : cconv[(size_t)(b * 2 + t) * 5632 + col];
            hcv[half] = cb[col] + cw[col] * um2 + cw[5632 + col] * um1 + cw[2 * 5632 + col] * u0; }
        ACT[(size_t)(cfg::MP + s) * cfg::FF + c] = (bf16)f2bf(gelu1(hcv[0]) * hcv[1]);
    }
#pragma unroll 2
    for (int e = F.vcu * 512 + F.tid; e < 128 * 2 * cfg::NUP; e += F.G * 512) {
        const int b = e / (2 * cfg::NUP), r = e % (2 * cfg::NUP), j = r / cfg::NUP, col = r % cfg::NUP;
        a->out[cfg::O_CS + (size_t)((layer * 128 + b) * 2 + j) * 5632 + col] = UPS[(size_t)(b * 8 + 6 + j) * 5632 + col]; }
}

__device__ __forceinline__ int lane_id() { unsigned ones = ~0u; asm volatile("" : "+s"(ones) :: "memory"); return (int)__builtin_amdgcn_mbcnt_hi(ones, __builtin_amdgcn_mbcnt_lo(ones, 0u)); }
__device__ __forceinline__ void make_frame(Frame& F, LAS unsigned char* lds, const int wave_s) {
    const int l = lane_id();
    F.lds = lds; F.MISC = (volatile LAS unsigned*)(lds + MISC_OFF); F.tid = wave_s * 64 + l; F.lane = l; F.wave = wave_s;
    F.G = gridDim.x; { const int bx = blockIdx.x; F.vcu = (F.G % 8 == 0) ? (bx % 8) * (F.G / 8) + bx / 8 : bx; }
}
__device__ __forceinline__ ArgsP get_args() { ArgsP p = (ArgsP)__builtin_amdgcn_kernarg_segment_ptr(); asm volatile("" : "+s"(p) :: "memory"); return p; }
__device__ __forceinline__ void grid_bar(LAS unsigned char* lds, const int wave_s) {
    ArgsP a = get_args(); XcdBarrier b; b.bar = (unsigned*)(a->ws + WS_CTL) + CW_BAR; b.x = xb_xcc_id(); b.st = (volatile LAS unsigned*)(lds + MISC_OFF) + 8; xcd_barrier(b, wave_s == 0 && lane_id() == 0);
}
#define GRID_BAR() grid_bar(lds, wave_s)
#define PHASE_BEGIN Frame F; make_frame(F, lds, wave_s); ArgsP a = get_args(); unsigned char* ws = a->ws; (void)ws; (void)F;
template <int LAYER> __device__ __forceinline__ void run_layer(LAS unsigned char* lds, const int wave_s) {
    constexpr int layer = LAYER;
#ifndef SKIP_P1
        {
            PHASE_BEGIN const unsigned char* wl = ws + WS_W + (size_t)layer * W_LAYER;
            pg8::Gemm g{(const pg8::bf16_t*)(ws + WS_XB), (const pg8::bf16_t*)(wl + W_IN), cfg::M, cfg::NIN, cfg::D}; pg8::StaticOrder S; S.init(cfg::M, cfg::NIN, F.G, (int)blockIdx.x);
            pg8::EpiIn E{(bf16*)(ws + WS_MIX), (bf16*)(ws + WS_ZV), (bf16*)(ws + WS_KB), (bf16*)(ws + WS_VB), (const float*)(ws + WS_ROPE), a->in[6] + layer * 512, a->in[7] + layer * 512, a->out, layer};
            pg8::gemm_phase<pg8::EpiIn, pg8::StaticOrder, true, true>(F.lds + RING_OFF, g, S, E, wave_s);
        }
#endif
        GRID_BAR();
#ifndef SKIP_P2A
        { PHASE_BEGIN p2_gmlp_prompt(F, a, layer); }
#endif
#ifndef SKIP_P2B
        { PHASE_BEGIN p2_attn_prompt(F, a, layer); }
#endif
#ifndef SKIP_P2C
        { PHASE_BEGIN p2_sample(F, a, layer); }
#endif
        GRID_BAR();
#ifndef SKIP_P3
        {
            PHASE_BEGIN const unsigned char* wl = ws + WS_W + (size_t)layer * W_LAYER; float* Y = a->out + cfg::O_Y;
            pg8::Gemm g{(const pg8::bf16_t*)(ws + WS_MIX), (const pg8::bf16_t*)(wl + W_OUT), cfg::M, cfg::D, cfg::D}; pg8::StaticOrder S; S.init(cfg::M, cfg::D, F.G, (int)blockIdx.x);
            pg8::EpiRes E{layer == 0 ? a->in[0] : (const float*)Y, layer == 0 ? a->in[1] : (const float*)(Y + (size_t)cfg::MP * 1024), Y};
            pg8::gemm_phase<pg8::EpiRes, pg8::StaticOrder, true, true>(F.lds + RING_OFF, g, S, E, wave_s);
        }
#endif
        GRID_BAR();
        { PHASE_BEGIN ln_rows(F, a->out + cfg::O_Y, (bf16*)(ws + WS_XB), a->in[12] + layer * 1024, a->in[13] + layer * 1024); }
        GRID_BAR();
#ifndef SKIP_P4
        {
            PHASE_BEGIN const unsigned char* wl = ws + WS_W + (size_t)layer * W_LAYER;
            pg8::Gemm g{(const pg8::bf16_t*)(ws + WS_XB), (const pg8::bf16_t*)(wl + W_UP), cfg::M, cfg::NUP, cfg::D}; pg8::StaticOrder S; S.init(cfg::M, cfg::NUP, F.G, (int)blockIdx.x);
            pg8::EpiUp E{(bf16*)(ws + WS_ACT), a->in[15] + (size_t)layer * 3 * cfg::NUP, a->in[16] + (size_t)layer * cfg::NUP, (float*)(ws + WS_UPS), a->out,
                         (float*)(ws + WS_HF), (float*)(ws + WS_HL), F.lds + XCH_OFF, layer};
            pg8::gemm_phase<pg8::EpiUp, pg8::StaticOrder, true, true>(F.lds + RING_OFF, g, S, E, wave_s);
        }
#endif
        GRID_BAR();
        { PHASE_BEGIN p4_fixup(F, a, layer); }
        GRID_BAR();
#ifndef SKIP_P5
        {
            PHASE_BEGIN const unsigned char* wl = ws + WS_W + (size_t)layer * W_LAYER; float* Y = a->out + cfg::O_Y;
            pg8::Gemm g{(const pg8::bf16_t*)(ws + WS_ACT), (const pg8::bf16_t*)(wl + W_DOWN), cfg::M, cfg::D, cfg::FF}; pg8::StaticOrder S; S.init(cfg::M, cfg::D, F.G, (int)blockIdx.x);
            pg8::EpiRes E{(const float*)Y, (const float*)(Y + (size_t)cfg::MP * 1024), Y};
            pg8::gemm_phase<pg8::EpiRes, pg8::StaticOrder, true, true>(F.lds + RING_OFF, g, S, E, wave_s);
        }
#endif
        GRID_BAR();
        { PHASE_BEGIN ln_rows(F, a->out + cfg::O_Y, (bf16*)(ws + WS_XB), a->in[18] + layer * 1024, a->in[19] + layer * 1024); }
        if (layer == 0) GRID_BAR();
}
__global__ void __launch_bounds__(NWAVES * 64, 2) trunk_fwd(Args args_by_kernarg_segment) {
    extern __shared__ __attribute__((aligned(16))) unsigned char lds_[];
    LAS unsigned char* lds = (LAS unsigned char*)lds_;
    const int wave_s = __builtin_amdgcn_readfirstlane(threadIdx.x >> 6);
    for (int u = wave_s * 64 + lane_id(); u < (LDS_BYTES - LDSCTL_OFF) / 4; u += NWAVES * 64) ((LAS unsigned*)(lds + LDSCTL_OFF))[u] = 0u;
    __syncthreads();
    { ArgsP a = get_args(); (void)xcd_barrier_post((unsigned*)(a->ws + WS_CTL) + CW_BAR, (volatile LAS unsigned*)(lds + MISC_OFF) + 8, wave_s == 0 && lane_id() == 0); }
#ifndef SKIP_P0
    { PHASE_BEGIN p0_prologue(F, a); }
#endif
    GRID_BAR();
    run_layer<0>(lds, wave_s);
    run_layer<1>(lds, wave_s);
}

extern "C" void kernel_launch(void* const* d_in, const int* in_sizes, int n_in, void* d_out, int out_size, void* d_ws, size_t ws_size, hipStream_t stream) {
    static int grid = 0;
    if (grid == 0) {
        if (n_in != 20 || out_size != (int)cfg::O_END || ws_size < WS_END) { fprintf(stderr, "kernel_launch: unexpected shapes (n_in %d, out %d, ws %zu); nothing launched\n", n_in, out_size, ws_size); grid = -1; return; }
        int dev = 0, cus = 0;
        if (hipGetDevice(&dev) != hipSuccess || hipDeviceGetAttribute(&cus, hipDeviceAttributeMultiprocessorCount, dev) != hipSuccess) { grid = -1; return; }
        if (hipFuncSetAttribute((const void*)trunk_fwd, hipFuncAttributeMaxDynamicSharedMemorySize, LDS_BYTES) != hipSuccess) { fprintf(stderr, "kernel_launch: hipFuncSetAttribute failed\n"); grid = -1; return; }
        (void)hipGetLastError();
        grid = cus;
    }
    if (grid < 0) return;
    if (hipMemsetAsync((char*)d_ws + WS_CTL, 0, CTL_ZERO_BYTES, stream) != hipSuccess) { fprintf(stderr, "kernel_launch: hipMemsetAsync failed\n"); return; }
    Args a{};
    for (int i = 0; i < 20; ++i) a.in[i] = (const float*)d_in[i];
    a.out = (float*)d_out; a.ws = (unsigned char*)d_ws;
    for (int i = 0; i < 32; ++i) a.inv_freq[i] = (float)pow(10000.0, -(double)i / 32.0);
    hipLaunchKernelGGL(trunk_fwd, dim3(grid), dim3(NWAVES * 64), LDS_BYTES, stream, a);
}
```

```cpp
#define NO_XCHG 1
#include <hip/hip_runtime.h>
#include <cstdio>
#include <cstdint>
#include <cmath>

namespace cfg {
constexpr int D = 1024, NIN = 1792, FF = 2816, NUP = 5632, MP = 16384, MS = 1024, M = MP + MS, SEQ = 4096;
constexpr size_t O_Y = 0, O_KP = 17825792, O_VP = 17956864, O_CP = 18087936, O_KS = 18178048, O_VS = 22372352, O_CS = 26566656, O_GS = 29450240, O_END = 30498816;
constexpr float ALPHA = 1.41421356237309515f, LN_EPS = 1e-5f;
}
namespace pg8 {
#define PG8_LAS __attribute__((address_space(3)))
typedef unsigned short bf16_t;
typedef short bf16x8 __attribute__((ext_vector_type(8)));
typedef float f32x4 __attribute__((ext_vector_type(4)));
typedef unsigned u32x4 __attribute__((ext_vector_type(4)));
constexpr int BM = 256, BK = 64, HALF = 128, HTB = HALF * BK * 2  , STAGE_BYTES = 8 * HTB, NXCD = 8, WGM = 8;

__host__ __device__ __forceinline__ int lds_byte(int r, int c) { const int st = (r >> 4) * 2 + (c >> 5), rr = r & 15, cc = c & 31, ob = rr * 64 + cc * 2; return st * 1024 + (ob ^ (((ob >> 9) & 1) << 5)); }
__host__ __device__ __forceinline__ void stage_rc(int b, int& R, int& C) { const int st = b / 1024, sb = b % 1024, swz = sb ^ (((sb >> 9) & 1) << 5); R = (st >> 1) * 16 + swz / 64; C = (st & 1) * 32 + (swz % 64) / 2; }
__host__ __device__ __forceinline__ int perm32(int rho) { const int n = rho >> 4, i = rho & 15; return 8 * (i >> 2) + 4 * n + (i & 3); }

struct Unit { int pm, pn; };
struct Gemm { const bf16_t* A; const bf16_t* Bt; int M, N, K; };

struct StaticOrder {
    int nM, nN, nwg, G, c;
    __host__ __device__ void init(int M, int N, int G_, int c_) { nM = M / BM; nN = N / BM; nwg = nM * nN; G = G_; c = c_; }
    __host__ __device__ bool next(int i, Unit& u) const {
        const long L = (long)i * G + c; if (L >= nwg) return false;
        int wgid = (int)L; { const int q = nwg / NXCD, r = nwg % NXCD, xcd = wgid % NXCD, off = wgid / NXCD; wgid = (xcd < r ? xcd * (q + 1) : r * (q + 1) + (xcd - r) * q) + off; }
        const int nig = WGM * nN, gid = wgid / nig, fm = gid * WGM, gsz = (nM - fm) < WGM ? (nM - fm) : WGM;
        u.pm = fm + ((wgid % nig) % gsz); u.pn = (wgid % nig) / gsz; return true;
    }
    __device__ __forceinline__ void a_ready(const Unit&) const {}
    __device__ __forceinline__ void done(const Unit&) const {}
};

__device__ __forceinline__ unsigned cvt_pk_bf16(float lo, float hi) { unsigned r; asm volatile("v_cvt_pk_bf16_f32 %0, %1, %2" : "=v"(r) : "v"(lo), "v"(hi)); return r; }
typedef float f32x2 __attribute__((ext_vector_type(2)));
__device__ __forceinline__ f32x2 gelu_pk(f32x2 v) {
    const f32x2 av = __builtin_elementwise_abs(v), d = av * 0.2316418882f + 1.0f;
    f32x2 t; t.x = __builtin_amdgcn_rcpf(d.x); t.y = __builtin_amdgcn_rcpf(d.y);
    f32x2 q = t * 0.5307027145f + (-0.7265760135f); q = q * t + 0.7107068705f; q = q * t + (-0.142248368f); q = q * t + 0.127414796f; q = q * t;
    const f32x2 s = (v * v) * (-0.72134752044f);
    f32x2 e; e.x = __builtin_amdgcn_exp2f(s.x); e.y = __builtin_amdgcn_exp2f(s.y);
    const f32x2 m = v * (q * e), r = v - m;
    f32x2 o; o.x = v.x < 0.f ? m.x : r.x; o.y = v.y < 0.f ? m.y : r.y; return o;
}

typedef unsigned u32x2 __attribute__((ext_vector_type(2)));
__device__ __forceinline__ f32x4 gelu4(f32x4 v) { const f32x2 a = gelu_pk((f32x2){v[0], v[1]}), b = gelu_pk((f32x2){v[2], v[3]}); return (f32x4){a.x, a.y, b.x, b.y}; }
__device__ __forceinline__ u32x4 pack8(f32x4 a, f32x4 b) { u32x4 w; w.x = cvt_pk_bf16(a[0], a[1]); w.y = cvt_pk_bf16(a[2], a[3]); w.z = cvt_pk_bf16(b[0], b[1]); w.w = cvt_pk_bf16(b[2], b[3]); return w; }
__device__ __forceinline__ float sum4(f32x4 v) { return (v[0] + v[1]) + (v[2] + v[3]); }

struct EpiIn {
    static constexpr bool PERM = false, AFTER_DRAIN = false;
    bf16_t* MIX; bf16_t* ZV; bf16_t* KB; bf16_t* VB; const float* rope; const float* lng; const float* lnb; float* out; int layer;
    __device__ __forceinline__ void operator()(const f32x4 (&acc)[2][2][4][2], const Unit& u, int wr, int wc, int fr_, int fq_) const {
        int fr = fr_, fq = fq_; asm volatile("" : "+v"(fr), "+v"(fq) :: "memory");
        const int hg = 4 * u.pn + wc, dcol = 8 * fq, layer_ = layer;
        if (hg < 8) {
#pragma unroll
            for (int ai = 0; ai < 2; ++ai)
#pragma unroll
                for (int m = 0; m < 4; ++m) { const int row = u.pm * 256 + ai * 128 + wr * 64 + m * 16 + fr; bf16_t* rp = MIX + (size_t)row * 1024 + 64 * hg + dcol;
#pragma unroll
                    for (int bj = 0; bj < 2; ++bj) *(u32x4*)(rp + 32 * bj) = pack8(gelu4(acc[ai][bj][m][0]), gelu4(acc[ai][bj][m][1])); }
        } else if (hg < 16) {
            const int h = hg - 8;
            f32x4 gw[2][2], gb[2][2];
#pragma unroll
            for (int bj = 0; bj < 2; ++bj)
#pragma unroll
                for (int n = 0; n < 2; ++n) { gw[bj][n] = *(const f32x4*)(lng + h * 64 + 32 * bj + dcol + 4 * n); gb[bj][n] = *(const f32x4*)(lnb + h * 64 + 32 * bj + dcol + 4 * n); }
#pragma unroll
            for (int ai = 0; ai < 2; ++ai)
#pragma unroll
                for (int m = 0; m < 4; ++m) { const int row = u.pm * 256 + ai * 128 + wr * 64 + m * 16 + fr;
                    f32x4 g[2][2]; float s = 0.f;
#pragma unroll
                    for (int bj = 0; bj < 2; ++bj)
#pragma unroll
                        for (int n = 0; n < 2; ++n) { g[bj][n] = gelu4(acc[ai][bj][m][n]); s += sum4(g[bj][n]); }
                    s += __shfl_xor(s, 16); s += __shfl_xor(s, 32);
                    const float mean = s * (1.0f / 64.0f); float q = 0.f;
#pragma unroll
                    for (int bj = 0; bj < 2; ++bj)
#pragma unroll
                        for (int n = 0; n < 2; ++n) { g[bj][n] = g[bj][n] - mean; q += sum4(g[bj][n] * g[bj][n]); }
                    q += __shfl_xor(q, 16); q += __shfl_xor(q, 32);
                    const float rstd = 1.0f / sqrtf(q * (1.0f / 64.0f) + cfg::LN_EPS);
#pragma unroll
                    for (int bj = 0; bj < 2; ++bj)
#pragma unroll
                        for (int n = 0; n < 2; ++n) g[bj][n] = g[bj][n] * rstd * gw[bj][n] + gb[bj][n];
                    bf16_t* rp = ZV + (size_t)row * 512 + 64 * h + dcol;
#pragma unroll
                    for (int bj = 0; bj < 2; ++bj) *(u32x4*)(rp + 32 * bj) = pack8(g[bj][0], g[bj][1]);
                    if (row >= cfg::MP) { float* op = out + cfg::O_GS + ((size_t)(layer_ * 1024 + (row - cfg::MP))) * 512 + 64 * h + dcol;
#pragma unroll
                        for (int bj = 0; bj < 2; ++bj)
#pragma unroll
                            for (int n = 0; n < 2; ++n) *(f32x4*)(op + 32 * bj + 4 * n) = g[bj][n]; }
                }
        } else {
            const bool isv = hg >= 26, isq = hg < 24;
#pragma unroll
            for (int ai = 0; ai < 2; ++ai)
#pragma unroll
                for (int m = 0; m < 4; ++m) { const int row = u.pm * 256 + ai * 128 + wr * 64 + m * 16 + fr;
                    f32x4 o[2][2];
                    if (!isv) { const int p = row < cfg::MP ? (row & 4095) : 4096 + (row & 7);
#pragma unroll
                        for (int n = 0; n < 2; ++n) { const f32x4* rp = (const f32x4*)(rope + ((size_t)p * 32 + dcol + 4 * n) * 2); const f32x4 cs0 = rp[0], cs1 = rp[1];
                            const f32x4 c = (f32x4){cs0[0], cs0[2], cs1[0], cs1[2]}, s = (f32x4){cs0[1], cs0[3], cs1[1], cs1[3]}; const f32x4 x1 = acc[ai][0][m][n], x2 = acc[ai][1][m][n];
                            o[0][n] = x1 * c - x2 * s; o[1][n] = x2 * c + x1 * s; }
                    } else {
#pragma unroll
                        for (int bj = 0; bj < 2; ++bj)
#pragma unroll
                            for (int n = 0; n < 2; ++n) o[bj][n] = acc[ai][bj][m][n]; }
                    if (isq) { bf16_t* rp = MIX + (size_t)row * 1024 + 512 + 64 * (hg - 16) + dcol;
#pragma unroll
                        for (int bj = 0; bj < 2; ++bj) *(u32x4*)(rp + 32 * bj) = pack8(o[bj][0] * 0.125f, o[bj][1] * 0.125f);
                    } else { const int kvh = (hg - 24) & 1; bf16_t* rp = (isv ? VB : KB) + (size_t)row * 128 + 64 * kvh + dcol;
#pragma unroll
                        for (int bj = 0; bj < 2; ++bj) *(u32x4*)(rp + 32 * bj) = pack8(o[bj][0], o[bj][1]);
                        float* op = nullptr;
                        if (row < cfg::MP) { const int pos = row & 4095; if (pos >= 3968) op = out + (isv ? cfg::O_VP : cfg::O_KP) + ((size_t)((layer_ * 4 + (row >> 12)) * 128 + (pos - 3968)) * 2 + kvh) * 64 + dcol; }
                        else { const int sr = row - cfg::MP; op = out + (isv ? cfg::O_VS : cfg::O_KS) + ((size_t)((layer_ * 128 + (sr >> 3)) * 128 + 120 + (sr & 7)) * 2 + kvh) * 64 + dcol; }
                        if (op) {
#pragma unroll
                            for (int bj = 0; bj < 2; ++bj)
#pragma unroll
                                for (int n = 0; n < 2; ++n) *(f32x4*)(op + 32 * bj + 4 * n) = o[bj][n]; }
                    }
                }
        }
    }
};

struct EpiRes {
    static constexpr bool PERM = false, AFTER_DRAIN = false;
    const float* resP; const float* resS; float* Y;
    __device__ __forceinline__ void operator()(const f32x4 (&acc)[2][2][4][2], const Unit& u, int wr, int wc, int fr_, int fq_) const {
        int fr = fr_, fq = fq_; asm volatile("" : "+v"(fr), "+v"(fq) :: "memory");
        const int col0 = u.pn * 256 + wc * 32 + 4 * fq;
#pragma unroll
        for (int ai = 0; ai < 2; ++ai)
#pragma unroll
            for (int m = 0; m < 4; ++m) { const int row = u.pm * 256 + ai * 128 + wr * 64 + m * 16 + fr;
                const float* rp = (row < cfg::MP ? resP + (size_t)row * 1024 : resS + (size_t)(row - cfg::MP) * 1024) + col0; float* yp = Y + (size_t)row * 1024 + col0;
                f32x4 x[2][2];
#pragma unroll
                for (int bj = 0; bj < 2; ++bj)
#pragma unroll
                    for (int n = 0; n < 2; ++n) x[bj][n] = *(const f32x4*)(rp + bj * 128 + n * 16);
#pragma unroll
                for (int bj = 0; bj < 2; ++bj)
#pragma unroll
                    for (int n = 0; n < 2; ++n) *(f32x4*)(yp + bj * 128 + n * 16) = x[bj][n] * cfg::ALPHA + acc[ai][bj][m][n];
            }
    }
};

struct EpiUp {
    static constexpr bool PERM = false, AFTER_DRAIN = false;
    bf16_t* ACT; const float* cw; const float* cb; float* UPS; float* out; float* HF; float* HL; PG8_LAS unsigned char* xl; int layer;
    __device__ __forceinline__ void operator()(const f32x4 (&acc)[2][2][4][2], const Unit& u, int wr, int wc, int fr_, int fq_) const {
        int fr = fr_, fq = fq_; asm volatile("" : "+v"(fr), "+v"(fq) :: "memory");
        const int wid = wr * 4 + wc, lane = fq * 16 + fr, pm = u.pm, pn = u.pn, layer_ = layer;
        const int gcol = 128 * pn + 32 * wc + 8 * fq;
        PG8_LAS f32x4* X = (PG8_LAS f32x4*)xl;
#define EPIUP_SHF(v, l) __builtin_bit_cast(float, __builtin_amdgcn_ds_bpermute((l), __builtin_bit_cast(int, (v))))
        if (pm >= 64) {
#pragma unroll
            for (int ai = 0; ai < 2; ++ai)
#pragma unroll
                for (int m = 0; m < 4; ++m) { float* rp = UPS + (size_t)(pm * 256 + ai * 128 + wr * 64 + m * 16 + fr - cfg::MP) * 5632 + gcol;
#pragma unroll
                    for (int bj = 0; bj < 2; ++bj)
#pragma unroll
                        for (int n = 0; n < 2; ++n) *(f32x4*)(rp + bj * 2816 + 4 * n) = acc[ai][bj][m][n]; }
            return;
        }
        if (fr >= 14) {
#pragma unroll
            for (int ai = 0; ai < 2; ++ai)
#pragma unroll
                for (int bj = 0; bj < 2; ++bj)
#pragma unroll
                    for (int n = 0; n < 2; ++n) X[((((wid * 2 + ai) * 2 + bj) * 2 + n) * 4 + fq) * 2 + (fr - 14)] = acc[ai][bj][3][n];
        }
        {
#pragma unroll
            for (int ai = 0; ai < 2; ++ai) { const int q = pm * 4 + ai * 2 + wr;
                if (fr < 2) {
#pragma unroll
                    for (int bj = 0; bj < 2; ++bj)
#pragma unroll
                        for (int n = 0; n < 2; ++n) *(f32x4*)(HF + (size_t)(q * 2 + fr) * 5632 + bj * 2816 + gcol + 4 * n) = acc[ai][bj][0][n];
                }
                if (fr >= 14) {
#pragma unroll
                    for (int bj = 0; bj < 2; ++bj)
#pragma unroll
                        for (int n = 0; n < 2; ++n) { *(f32x4*)(HL + (size_t)(q * 2 + (fr - 14)) * 5632 + bj * 2816 + gcol + 4 * n) = acc[ai][bj][3][n];
                            if ((pm & 15) == 15 && ai == 1 && wr == 1) *(f32x4*)(out + cfg::O_CP + (size_t)((layer_ * 4 + (pm >> 4)) * 2 + (fr - 14)) * 5632 + bj * 2816 + gcol + 4 * n) = acc[ai][bj][3][n]; }
                }
            }
        }
        asm volatile("s_waitcnt lgkmcnt(0)" ::: "memory"); __builtin_amdgcn_s_barrier(); asm volatile("" ::: "memory");
        const int l1 = ((lane & 48) | ((fr - 1) & 15)) * 4, l2 = ((lane & 48) | ((fr - 2) & 15)) * 4;
#pragma unroll
        for (int ai = 0; ai < 2; ++ai) {
            int sw = 0, sa = 0; bool have = true;
            if (wr == 1) { sw = wid - 4; sa = ai; } else if (ai == 1) { sw = wid + 4; sa = 0; } else have = false;
#ifdef NO_XCHG
            have = false;
#endif
            const int rowb = pm * 256 + ai * 128 + wr * 64 + fr;
#pragma unroll
            for (int n = 0; n < 2; ++n) {
                u32x2 wpk[4];
#pragma unroll
                for (int ip = 0; ip < 2; ++ip) {
                    f32x2 hcu[4];
#pragma unroll
                    for (int bj = 1; bj >= 0; --bj) {
                        const unsigned cby = (unsigned)(bj * 2816 + gcol + 4 * n + 2 * ip) * 4u;
                        const f32x2 w0 = *(const f32x2*)((const char*)cw + cby), w1 = *(const f32x2*)((const char*)cw + (cby + 5632u * 4u)), w2 = *(const f32x2*)((const char*)cw + (cby + 2u * 5632u * 4u)), b0 = *(const f32x2*)((const char*)cb + cby);
                        f32x2 xm1 = (f32x2){0.f, 0.f};
                        if (have && fr >= 14) xm1 = *(const PG8_LAS f32x2*)((const PG8_LAS float*)(X + ((((sw * 2 + sa) * 2 + bj) * 2 + n) * 4 + fq) * 2 + (fr - 14)) + 2 * ip);
                        float t1m[2], t2m[2];
#pragma unroll
                        for (int e = 0; e < 2; ++e) { t1m[e] = EPIUP_SHF(xm1[e], l1); t2m[e] = EPIUP_SHF(xm1[e], l2); }
#pragma unroll
                        for (int m = 0; m < 4; ++m) {
                            f32x2 hc;
#pragma unroll
                            for (int e = 0; e < 2; ++e) { const float x = acc[ai][bj][m][n][2 * ip + e];
                                const float t1 = EPIUP_SHF(x, l1), t2 = EPIUP_SHF(x, l2); const float p1 = fr >= 1 ? t1 : t1m[e], p2 = fr >= 2 ? t2 : t2m[e];
                                hc[e] = b0[e] + w0[e] * p2 + w1[e] * p1 + w2[e] * x; t1m[e] = t1; t2m[e] = t2; }
                            if (bj == 1) hcu[m] = hc;
                            else { const f32x2 gg = gelu_pk(hc); const unsigned w = cvt_pk_bf16(gg.x * hcu[m].x, gg.y * hcu[m].y); if (ip == 0) wpk[m].x = w; else wpk[m].y = w; }
                        }
                        asm volatile("" ::: "memory");
                    }
                }
#pragma unroll
                for (int m = 0; m < 4; ++m) *(u32x2*)(ACT + (size_t)(rowb + 16 * m) * 2816 + gcol + 4 * n) = wpk[m];
            }
        }
#undef EPIUP_SHF
    }
};
template <class Epi, class Sched, bool ALIGN_EPI = false, bool SP2 = false>
__device__ __forceinline__ void gemm_phase(PG8_LAS unsigned char* lds, const Gemm g, const Sched& S, const Epi& E, const int wid_s  ) {
    unsigned ones_ = ~0u; asm volatile("" : "+s"(ones_) :: "memory"); const int lane_ = (int)__builtin_amdgcn_mbcnt_hi(ones_, __builtin_amdgcn_mbcnt_lo(ones_, 0u));
    const int wid = wid_s, lane = lane_, tid = wid * 64 + lane, wr = wid >> 2, wc = wid & 3, fr = lane & 15, fq = lane >> 4;
    const int K = g.K, nt = K / BK;
    unsigned voffA[2], voffB[2];
#pragma unroll
    for (int i = 0; i < 2; ++i) { int R, C; stage_rc(tid * 16 + i * 8192, R, C); const int Rb = Epi::PERM ? ((R & ~31) + perm32(R & 31)) : R;
        voffA[i] = (unsigned)(R * K + C) * 2u; voffB[i] = (unsigned)(Rb * K + C) * 2u; }
    const size_t kstep = (size_t)(BK * 2);
    const size_t hstep = (size_t)HALF * K * 2;
    const size_t tstep = 2 * hstep;
    const unsigned ldsw = (unsigned)wid * 1024u;
    const int aoff = lds_byte(wr * 64 + fr, fq * 8), boff = lds_byte(wc * 32 + fr, fq * 8);
#define PG8_SA(b, h) (((b) * 2 + (h)) * HTB)
#define PG8_SB(b, h) ((4 + (b) * 2 + (h)) * HTB)
#define PG8_STAGE(bufoff, gbase, voff) do { _Pragma("unroll") for (int _i = 0; _i < 2; ++_i) \
        __builtin_amdgcn_global_load_lds((const unsigned*)((const char*)(gbase) + (voff)[_i]), (PG8_LAS unsigned*)(lds + (bufoff) + ldsw + _i * 8192), 16, 0, 0); } while (0)
#define PG8_LDA(dst, b, h) do { _Pragma("unroll") for (int m = 0; m < 4; ++m) _Pragma("unroll") for (int k = 0; k < 2; ++k) dst[m][k] = *(const PG8_LAS bf16x8*)(lds + PG8_SA(b, h) + aoff + m * 2048 + k * 1024); } while (0)
#define PG8_LDB(dst, b, h) do { _Pragma("unroll") for (int n = 0; n < 2; ++n) _Pragma("unroll") for (int k = 0; k < 2; ++k) dst[n][k] = *(const PG8_LAS bf16x8*)(lds + PG8_SB(b, h) + boff + n * 2048 + k * 1024); } while (0)
#define PG8_MMA(ai, bj, At, Bt) do { __builtin_amdgcn_s_setprio(1); _Pragma("unroll") for (int m = 0; m < 4; ++m) _Pragma("unroll") for (int n = 0; n < 2; ++n) _Pragma("unroll") for (int k = 0; k < 2; ++k) \
        acc[ai][bj][m][n] = __builtin_amdgcn_mfma_f32_16x16x32_bf16(Bt[n][k], At[m][k], acc[ai][bj][m][n], 0, 0, 0); __builtin_amdgcn_s_setprio(0); } while (0)
#define PG8_WAIT_V(n) asm volatile("s_waitcnt vmcnt(" #n ")" ::: "memory")
#define PG8_WAIT_L(n) asm volatile("s_waitcnt lgkmcnt(" #n ")" ::: "memory")
#define PG8_BAR __builtin_amdgcn_s_barrier()
#define PG8_SCHED __builtin_amdgcn_sched_barrier(0)
    Unit cur, nxt; int ui = 0;
    if (!S.next(0, cur)) return;
    f32x4 acc[2][2][4][2];
#pragma unroll
    for (int a = 0; a < 2; ++a)
#pragma unroll
        for (int b = 0; b < 2; ++b)
#pragma unroll
            for (int m = 0; m < 4; ++m)
#pragma unroll
                for (int n = 0; n < 2; ++n) acc[a][b][m][n] = (f32x4){0.f, 0.f, 0.f, 0.f};
    bf16x8 At[4][2], B0[2][2], B1[2][2];
    const char* cA = (const char*)g.A + (size_t)cur.pm * tstep; const char* cB = (const char*)g.Bt + (size_t)cur.pn * tstep;
    S.a_ready(cur);
    if constexpr (SP2) {
        PG8_STAGE(PG8_SB(0, 0), cB, voffB); PG8_STAGE(PG8_SB(0, 1), cB + hstep, voffB); PG8_STAGE(PG8_SA(0, 0), cA, voffA); PG8_STAGE(PG8_SA(0, 1), cA + hstep, voffA);
        if (wr == 1) PG8_BAR;
        PG8_WAIT_V(2); PG8_BAR;
        PG8_STAGE(PG8_SB(1, 0), cB + kstep, voffB); PG8_STAGE(PG8_SA(1, 0), cA + kstep, voffA); PG8_STAGE(PG8_SB(1, 1), cB + hstep + kstep, voffB);
        PG8_WAIT_V(6); PG8_BAR;
    } else {
        PG8_STAGE(PG8_SB(0, 0), cB, voffB); PG8_STAGE(PG8_SA(0, 0), cA, voffA); PG8_STAGE(PG8_SB(0, 1), cB + hstep, voffB); PG8_STAGE(PG8_SA(0, 1), cA + hstep, voffA);
        if (wr == 1) PG8_BAR;
        PG8_WAIT_V(4); PG8_BAR;
        PG8_STAGE(PG8_SB(1, 0), cB + kstep, voffB); PG8_STAGE(PG8_SA(1, 0), cA + kstep, voffA); PG8_STAGE(PG8_SB(1, 1), cB + hstep + kstep, voffB);
        PG8_WAIT_V(6); PG8_BAR;
    }
    for (;;) {
        const bool has_next = S.next(ui + 1, nxt);
        const char* nA = has_next ? (const char*)g.A + (size_t)nxt.pm * tstep : cA; const char* nB = has_next ? (const char*)g.Bt + (size_t)nxt.pn * tstep : cB;
        for (int t = 0; t < nt; t += 2) {
            const bool last = (t == nt - 2);
            const char* a1 = cA + (size_t)(t + 1) * kstep;
            const char* a2 = last ? nA : cA + (size_t)(t + 2) * kstep; const char* b2 = last ? nB : cB + (size_t)(t + 2) * kstep;
            const char* a3 = a2 + kstep; const char* b3 = b2 + kstep;
            if (last && has_next) S.a_ready(nxt);
            if constexpr (SP2) {
            PG8_LDB(B0, 0, 0); PG8_LDB(B1, 0, 1); PG8_SCHED; PG8_LDA(At, 0, 0); PG8_STAGE(PG8_SA(1, 1), a1 + hstep, voffA);
            PG8_WAIT_V(8); PG8_WAIT_L(0); PG8_BAR; PG8_MMA(0, 0, At, B0); PG8_MMA(0, 1, At, B1); PG8_BAR; PG8_SCHED;
            PG8_LDA(At, 0, 1); PG8_STAGE(PG8_SB(0, 0), b2, voffB); PG8_STAGE(PG8_SB(0, 1), b2 + hstep, voffB); PG8_STAGE(PG8_SA(0, 0), a2, voffA);
            PG8_WAIT_V(8); PG8_WAIT_L(0); PG8_BAR; PG8_MMA(1, 0, At, B0); PG8_MMA(1, 1, At, B1); PG8_BAR; PG8_SCHED;
            PG8_LDB(B0, 1, 0); PG8_LDB(B1, 1, 1); PG8_SCHED; PG8_LDA(At, 1, 0); PG8_STAGE(PG8_SA(0, 1), a2 + hstep, voffA);
            PG8_WAIT_V(8); PG8_WAIT_L(0); PG8_BAR; PG8_MMA(0, 0, At, B0); PG8_MMA(0, 1, At, B1); PG8_BAR; PG8_SCHED;
            PG8_LDA(At, 1, 1); PG8_STAGE(PG8_SB(1, 0), b3, voffB); PG8_STAGE(PG8_SB(1, 1), b3 + hstep, voffB); PG8_STAGE(PG8_SA(1, 0), a3, voffA);
            PG8_WAIT_V(8); PG8_WAIT_L(0); PG8_BAR; PG8_MMA(1, 0, At, B0); PG8_MMA(1, 1, At, B1); PG8_BAR; PG8_SCHED;
            } else {
            PG8_LDB(B0, 0, 0); PG8_SCHED; PG8_LDA(At, 0, 0); PG8_STAGE(PG8_SA(1, 1), a1 + hstep, voffA);
            PG8_WAIT_L(8); PG8_BAR; PG8_WAIT_L(0); PG8_MMA(0, 0, At, B0); PG8_BAR; PG8_SCHED;
            PG8_LDB(B1, 0, 1); PG8_STAGE(PG8_SB(0, 0), b2, voffB);
            PG8_BAR; PG8_WAIT_L(0); PG8_MMA(0, 1, At, B1); PG8_BAR;
            PG8_LDA(At, 0, 1); PG8_STAGE(PG8_SA(0, 0), a2, voffA);
            PG8_BAR; PG8_WAIT_L(0); PG8_MMA(1, 0, At, B0); PG8_BAR; PG8_SCHED;
            PG8_STAGE(PG8_SB(0, 1), b2 + hstep, voffB);
            PG8_WAIT_V(6); PG8_BAR; PG8_MMA(1, 1, At, B1); PG8_BAR;
            PG8_LDB(B0, 1, 0); PG8_SCHED; PG8_LDA(At, 1, 0); PG8_STAGE(PG8_SA(0, 1), a2 + hstep, voffA);
            PG8_WAIT_L(8); PG8_BAR; PG8_WAIT_L(0); PG8_MMA(0, 0, At, B0); PG8_BAR; PG8_SCHED;
            PG8_LDB(B1, 1, 1); PG8_STAGE(PG8_SB(1, 0), b3, voffB);
            PG8_BAR; PG8_WAIT_L(0); PG8_MMA(0, 1, At, B1); PG8_BAR;
            PG8_LDA(At, 1, 1); PG8_STAGE(PG8_SA(1, 0), a3, voffA);
            PG8_BAR; PG8_WAIT_L(0); PG8_MMA(1, 0, At, B0); PG8_BAR; PG8_SCHED;
            PG8_STAGE(PG8_SB(1, 1), b3 + hstep, voffB);
            PG8_WAIT_V(6); PG8_BAR; PG8_MMA(1, 1, At, B1); PG8_BAR;
            }
        }
        if constexpr (ALIGN_EPI) { if (wr == 0) PG8_BAR; }
        if constexpr (!Epi::AFTER_DRAIN) { unsigned o2_ = ~0u; asm volatile("" : "+s"(o2_) :: "memory"); const int ln = (int)__builtin_amdgcn_mbcnt_hi(o2_, __builtin_amdgcn_mbcnt_lo(o2_, 0u)); E(acc, cur, wr, wc, ln & 15, ln >> 4); S.done(cur); }
        if (!has_next) break;
#pragma unroll
        for (int a = 0; a < 2; ++a)
#pragma unroll
            for (int b = 0; b < 2; ++b)
#pragma unroll
                for (int m = 0; m < 4; ++m)
#pragma unroll
                    for (int n = 0; n < 2; ++n) acc[a][b][m][n] = (f32x4){0.f, 0.f, 0.f, 0.f};
        cur = nxt; cA = nA; cB = nB; ++ui;
        if constexpr (ALIGN_EPI) { if (wr == 1) PG8_BAR; }
    }
    PG8_WAIT_V(0);
    if constexpr (!ALIGN_EPI) { if (wr == 0) PG8_BAR; }
    PG8_BAR;
    if constexpr (Epi::AFTER_DRAIN) { E.fused(acc, cur, wr, wc, fr, fq, lds, wid, lane); S.done(cur); }
#undef PG8_SA
#undef PG8_SB
#undef PG8_STAGE
#undef PG8_LDA
#undef PG8_LDB
#undef PG8_MMA
#undef PG8_WAIT_V
#undef PG8_WAIT_L
#undef PG8_BAR
#undef PG8_SCHED
}
}
#define GAS __attribute__((address_space(1)))
#define LAS __attribute__((address_space(3)))
typedef unsigned short bf16;
typedef unsigned v4u __attribute__((ext_vector_type(4)));
typedef float f32x4 __attribute__((ext_vector_type(4)));
typedef short bf16x8 __attribute__((ext_vector_type(8)));
typedef GAS unsigned gu32;
typedef GAS unsigned long long gu64;
#define RLX_AGENT __ATOMIC_RELAXED, __HIP_MEMORY_SCOPE_AGENT
#define LDS_WAIT() asm volatile("s_waitcnt lgkmcnt(0)" ::: "memory")
#define VM_WAIT() asm volatile("s_waitcnt vmcnt(0)" ::: "memory")
__device__ __forceinline__ unsigned long long rt() { return __builtin_amdgcn_s_memrealtime(); }
__device__ __forceinline__ unsigned f2bf(float f) { unsigned u = __builtin_bit_cast(unsigned, f); return (u + 0x7fffu + ((u >> 16) & 1u)) >> 16; }
__device__ __forceinline__ unsigned pk2(float lo, float hi) { return f2bf(lo) | (f2bf(hi) << 16); }

#define XB_TMO      128
#define XB_XCNT(j)  (256  + 64 * (j))
#define XB_XSUB(j)  (1280 + 64 * (j))
#define XB_XGEN(j)  (2304 + 64 * (j))
#define XB_TOP      3328
#define XB_TOPGEN   3392
#define XCD_BAR_WORDS 3456
#define XB_SPIN_CAP (1u << 18)

__device__ __forceinline__ unsigned xb_ld(unsigned* p)              { return __hip_atomic_load(p, __ATOMIC_RELAXED, __HIP_MEMORY_SCOPE_AGENT); }
__device__ __forceinline__ unsigned xb_add(unsigned* p, unsigned v) { return __hip_atomic_fetch_add(p, v, __ATOMIC_RELAXED, __HIP_MEMORY_SCOPE_AGENT); }
__device__ __forceinline__ unsigned xb_xcc_id() { return (unsigned)__builtin_amdgcn_s_getreg((3 << 11) | 20) & 0xFu; }
#define XB_SPIN(cond, bar) do { unsigned _sp = 0; while (cond) { __builtin_amdgcn_s_sleep(1); \
    if ((++_sp & 255u) == 0u) { if (xb_ld(&(bar)[XB_TMO])) break; if (_sp > XB_SPIN_CAP) { atomicAdd(&(bar)[XB_TMO], 1u); break; } } } } while (0)

struct XcdBarrier {
    unsigned* bar; unsigned x;
    volatile LAS unsigned* st;
};

__device__ __forceinline__ XcdBarrier xcd_barrier_post(unsigned* bar, volatile LAS unsigned* st, const bool leader) {
    XcdBarrier b; b.bar = bar; b.x = xb_xcc_id(); b.st = st;
    if (leader) (void)xb_add(&bar[XB_XCNT(b.x)], 1u);
    return b;
}
__device__ __forceinline__ void xcd_barrier_complete(unsigned* bar, unsigned x, unsigned& nloc, unsigned& nx) {
    const unsigned G = gridDim.x * gridDim.y * gridDim.z;
    unsigned sum, cnt, mine, sp = 0u;
    for (;;) {
        sum = 0u; cnt = 0u; mine = 0u;
#pragma unroll
        for (unsigned j = 0; j < 16; ++j) { const unsigned c = xb_ld(&bar[XB_XCNT(j)]); sum += c; cnt += (c > 0u) ? 1u : 0u; mine = (j == x) ? c : mine; }
        if (sum == G) break;
        __builtin_amdgcn_s_sleep(1);
        if ((++sp & 255u) == 0u) { if (xb_ld(&bar[XB_TMO])) break; if (sp > XB_SPIN_CAP) { atomicAdd(&bar[XB_TMO], 1u); break; } }
    }
    nloc = mine > 0u ? mine : 1u; nx = cnt > 0u ? cnt : 1u;
}

__device__ __forceinline__ void xcd_barrier(const XcdBarrier& b, const bool leader  ) {
    asm volatile("s_waitcnt vmcnt(0)" ::: "memory");
    __syncthreads();
    if (leader) {
        unsigned* bar = b.bar;
        __builtin_amdgcn_s_waitcnt(0);
        unsigned nloc = b.st[0], nx = b.st[1];
        if (nloc == 0u) { xcd_barrier_complete(bar, b.x, nloc, nx); b.st[0] = nloc; b.st[1] = nx; }
        const unsigned old = xb_add(&bar[XB_XSUB(b.x)], 1u);
        const unsigned gen = old / nloc;
        if (old + 1u == (gen + 1u) * nloc) {
            __builtin_amdgcn_fence(__ATOMIC_RELEASE, "agent");
            asm volatile("s_waitcnt vmcnt(0)" ::: "memory");
            const unsigned og = xb_add(&bar[XB_TOP], 1u);
            const unsigned tg = og / nx;
            if (og + 1u == (tg + 1u) * nx) xb_add(&bar[XB_TOPGEN], 1u);
            else XB_SPIN(xb_ld(&bar[XB_TOPGEN]) == tg, bar);
            __builtin_amdgcn_fence(__ATOMIC_ACQUIRE, "agent");
            xb_add(&bar[XB_XGEN(b.x)], 1u);
            asm volatile("s_waitcnt vmcnt(0)" ::: "memory");
        } else {
            XB_SPIN(xb_ld(&bar[XB_XGEN(b.x)]) == gen, bar);
            __builtin_amdgcn_fence(__ATOMIC_ACQUIRE, "agent");
            asm volatile("s_waitcnt vmcnt(0)" ::: "memory");
        }
    }
    __syncthreads();
}

constexpr int NWAVES = 8;
constexpr size_t MiB = 1u << 20;
constexpr size_t WS_CTL = 0, CTL_ZERO_BYTES = 1 * MiB;
constexpr size_t WS_ROPE = 1 * MiB;
constexpr size_t WS_W = 4 * MiB, W_LAYER = 22 * MiB;
constexpr size_t W_IN = 0, W_OUT = 3670016, W_UP = 5767168, W_DOWN = 17301504;
constexpr size_t WS_XB = 48 * MiB;
constexpr size_t WS_HF = 208 * MiB, WS_HL = 220 * MiB;
constexpr size_t WS_MIX = 90 * MiB;
constexpr size_t WS_ZV = 124 * MiB;
constexpr size_t WS_KB = 141 * MiB, WS_VB = 146 * MiB;
constexpr size_t WS_ACT = 90 * MiB;
constexpr size_t WS_UPS = 184 * MiB;
constexpr size_t WS_END = 232 * MiB;
constexpr int CW_BAR = 4096;
constexpr int RING_OFF = 0, RING_BYTES = 131072;
constexpr int XCH_OFF = RING_BYTES;
constexpr int LDSCTL_OFF = RING_BYTES + 8192, MISC_OFF = LDSCTL_OFF + 320;
constexpr int LDS_BYTES = 147456;
static_assert(MISC_OFF + 128 <= LDS_BYTES, "LDS map");

struct Frame {
    LAS unsigned char* lds; volatile LAS unsigned* MISC; gu32* ctl;
    int tid, lane, wave, vcu, G;
};
struct Args { const float* in[20]; float* out; unsigned char* ws; float inv_freq[32]; };
typedef const __attribute__((address_space(4))) Args* ArgsP;

__device__ __forceinline__ float bf2f(unsigned short b) { return __builtin_bit_cast(float, ((unsigned)b) << 16); }
__device__ __forceinline__ float bflo(unsigned w) { return __builtin_bit_cast(float, w << 16); }
__device__ __forceinline__ float bfhi(unsigned w) { return __builtin_bit_cast(float, w & 0xffff0000u); }
__device__ __forceinline__ float wave_sum(float v) {
#pragma unroll
    for (int o = 1; o < 64; o <<= 1) v += __shfl_xor(v, o);
    return v;
}
__device__ __forceinline__ float gelu1(float v) { const pg8::f32x2 r = pg8::gelu_pk((pg8::f32x2){v, v}); return r.x; }
__device__ __forceinline__ float fexp(float x) { return __builtin_amdgcn_exp2f(x * 1.4426950408889634f); }

__device__ __forceinline__ int dst_row(int mode, int n0, int n) {
    if (mode == 0) return n0 + n;
    const int slot = 16 * ((n >> 2) & 1) + 4 * (n >> 3) + (n & 3);
    if (mode == 1) return (n0 & ~255) + 128 * ((n0 >> 5) & 1) + 32 * ((n0 >> 6) & 3) + slot;
    const int c = n0 >= cfg::FF ? n0 - cfg::FF : n0;
    return 256 * (c >> 7) + (n0 >= cfg::FF ? 128 : 0) + 32 * ((c >> 5) & 3) + slot;
}
__device__ __forceinline__ void p0_transpose_item(const float* W, int K, int N, bf16* WT, int mode, LAS float* scr, int item, int lane) {
    const int nblk = N / 32, kb = item / nblk, nb = item % nblk, k0 = 64 * kb, n0 = 32 * nb;
#pragma unroll 8
    for (int i = 0; i < 32; ++i) { const int kk = 2 * i + (lane >> 5); scr[kk * 33 + (lane & 31)] = W[(size_t)(k0 + kk) * N + n0 + (lane & 31)]; }
    LDS_WAIT(); asm volatile("" ::: "memory");
    const int c = lane & 7;
#pragma unroll
    for (int j = 0; j < 4; ++j) { const int n = (lane >> 3) + 8 * j; const LAS float* s = scr + (8 * c) * 33 + n;
        v4u o; o.x = pk2(s[0 * 33], s[1 * 33]); o.y = pk2(s[2 * 33], s[3 * 33]); o.z = pk2(s[4 * 33], s[5 * 33]); o.w = pk2(s[6 * 33], s[7 * 33]);
        *(GAS v4u*)(WT + (size_t)dst_row(mode, n0, n) * K + k0 + 8 * c) = o; }
    LDS_WAIT(); asm volatile("" ::: "memory");
}
__device__ __forceinline__ void sincos_d(float ang, float& c, float& s) {
    const double x = (double)ang, k = __builtin_rint(x * 0.63661977236758134308);
    double r = __builtin_fma(-k, 1.57079632679489655800e+00, x); r = __builtin_fma(-k, 6.12323399573676603587e-17, r);
    const double r2 = r * r;
    const double sp = r * (1.0 + r2 * (-1.0 / 6 + r2 * (1.0 / 120 + r2 * (-1.0 / 5040 + r2 * (1.0 / 362880 + r2 * (-1.0 / 39916800))))));
    const double cp = 1.0 + r2 * (-0.5 + r2 * (1.0 / 24 + r2 * (-1.0 / 720 + r2 * (1.0 / 40320 + r2 * (-1.0 / 3628800 + r2 * (1.0 / 479001600))))));
    const int q = (int)k & 3;
    const double cc = (q == 0) ? cp : (q == 1) ? -sp : (q == 2) ? -cp : sp, ss = (q == 0) ? sp : (q == 1) ? cp : (q == 2) ? -sp : -cp;
    c = (float)cc; s = (float)ss;
}
__device__ __forceinline__ void p0_prologue(Frame& F, ArgsP a) {
    LAS float* scr = (LAS float*)(F.lds + RING_OFF + F.wave * 16384);
    const int gw = F.vcu * NWAVES + F.wave, NGW = F.G * NWAVES;
    bf16* wbase = (bf16*)(a->ws + WS_W);
    constexpr int I_IN = (cfg::D / 64) * (cfg::NIN / 32), I_OUT = (cfg::D / 64) * (cfg::D / 32), I_UP = (cfg::D / 64) * (cfg::NUP / 32), I_DN = (cfg::FF / 64) * (cfg::D / 32);
    constexpr int I_L = I_IN + I_OUT + I_UP + I_DN;
#pragma unroll 1
    for (int it = gw; it < 2 * I_L; it += NGW) {
        const int l = it / I_L; int r = it % I_L; bf16* wl = (bf16*)((unsigned char*)wbase + (size_t)l * W_LAYER);
        if (r < I_IN) { p0_transpose_item(a->in[5] + (size_t)l * cfg::D * cfg::NIN, cfg::D, cfg::NIN, (bf16*)((unsigned char*)wl + W_IN), 1, scr, r, F.lane); continue; } r -= I_IN;
        if (r < I_OUT) { p0_transpose_item(a->in[11] + (size_t)l * cfg::D * cfg::D, cfg::D, cfg::D, (bf16*)((unsigned char*)wl + W_OUT), 0, scr, r, F.lane); continue; } r -= I_OUT;
        if (r < I_UP) { p0_transpose_item(a->in[14] + (size_t)l * cfg::D * cfg::NUP, cfg::D, cfg::NUP, (bf16*)((unsigned char*)wl + W_UP), 2, scr, r, F.lane); continue; } r -= I_UP;
        p0_transpose_item(a->in[17] + (size_t)l * cfg::FF * cfg::D, cfg::FF, cfg::D, (bf16*)((unsigned char*)wl + W_DOWN), 0, scr, r, F.lane);
    }
    bf16* XB = (bf16*)(a->ws + WS_XB);
#pragma unroll 1
    for (int m = gw; m < cfg::M; m += NGW) {
        const float* xr = m < cfg::MP ? a->in[0] + (size_t)m * 1024 : a->in[1] + (size_t)(m - cfg::MP) * 1024;
        const GAS f32x4* x4 = (const GAS f32x4*)xr + F.lane; GAS unsigned long long* o8 = (GAS unsigned long long*)(XB + (size_t)m * 1024) + F.lane;
#pragma unroll
        for (int j = 0; j < 4; ++j) { const f32x4 v = x4[64 * j]; o8[64 * j] = (unsigned long long)pk2(v.x, v.y) | ((unsigned long long)pk2(v.z, v.w) << 32); }
    }
    {
        float invf = 0.f;
#pragma unroll
        for (int i = 0; i < 32; ++i) if ((F.tid & 31) == i) invf = a->inv_freq[i];
        float* tab = (float*)(a->ws + WS_ROPE);
#pragma unroll 1
        for (int e = (F.vcu * 512 + F.tid); e < 4104 * 32; e += F.G * 512) {
            const int p = e >> 5; const float pos = (float)(p < 4096 ? p : 16384 + (p - 4096)); float c, s; sincos_d(pos * invf, c, s);
            tab[2 * e] = c; tab[2 * e + 1] = s; }
    }
#pragma unroll 2
    for (int e = F.vcu * 512 + F.tid; e < 2 * 256 * 3840; e += F.G * 512) {
        const int kv = e / (256 * 3840), r = e % (256 * 3840), lb = r / 3840, q = r % 3840;
        const float* src = kv ? a->in[3] : a->in[2]; const f32x4 v = *((const GAS f32x4*)(src + (size_t)lb * 16384 + 1024) + q);
        *((GAS f32x4*)(a->out + (kv ? cfg::O_VS : cfg::O_KS) + (size_t)lb * 16384) + q) = v; }
}

__device__ __forceinline__ void ln_rows(Frame& F, float* Y, bf16* XB, const float* g, const float* b) {
    const int gw = F.vcu * NWAVES + F.wave, NGW = F.G * NWAVES;
    f32x4 gv[4], bv[4];
#pragma unroll
    for (int j = 0; j < 4; ++j) { gv[j] = *((const GAS f32x4*)g + F.lane + 64 * j); bv[j] = *((const GAS f32x4*)b + F.lane + 64 * j); }
#pragma unroll 1
    for (int m = gw; m < cfg::M; m += NGW) {
        GAS f32x4* yr = (GAS f32x4*)(Y + (size_t)m * 1024) + F.lane;
        f32x4 v[4]; float s = 0.f;
#pragma unroll
        for (int j = 0; j < 4; ++j) { v[j] = yr[64 * j]; s += (v[j].x + v[j].y) + (v[j].z + v[j].w); }
        const float mean = wave_sum(s) * (1.f / 1024.f); float s2 = 0.f;
#pragma unroll
        for (int j = 0; j < 4; ++j) { v[j] = v[j] - mean; s2 += (v[j].x * v[j].x + v[j].y * v[j].y) + (v[j].z * v[j].z + v[j].w * v[j].w); }
        const float rstd = 1.f / sqrtf(wave_sum(s2) * (1.f / 1024.f) + cfg::LN_EPS);
        GAS unsigned long long* o8 = (GAS unsigned long long*)(XB + (size_t)m * 1024) + F.lane;
#pragma unroll
        for (int j = 0; j < 4; ++j) { const f32x4 o = v[j] * rstd * gv[j] + bv[j]; yr[64 * j] = o; o8[64 * j] = (unsigned long long)pk2(o.x, o.y) | ((unsigned long long)pk2(o.z, o.w) << 32); }
    }
}

__device__ __forceinline__ void p2_gmlp_prompt(Frame& F, ArgsP a, int layer) {
    LAS float* Wl = (LAS float*)(F.lds);
    LAS float* Zl = (LAS float*)(F.lds + 66560);
    bf16* MIX = (bf16*)(a->ws + WS_MIX); const bf16* ZV = (const bf16*)(a->ws + WS_ZV);
    const float* Wsp = a->in[8] + (size_t)layer * 8 * 128 * 128; const float* bsp = a->in[9] + (size_t)layer * 8 * 128;
#pragma unroll 1
    for (int item = F.vcu; item < 1024; item += F.G) {
        const int h = item & 7, bc = item >> 3, row0 = (bc >> 5) * 4096 + (bc & 31) * 128;
        for (int k = 0; k < 32; ++k) { const int idx = F.tid + 512 * k, t = idx >> 7, s = idx & 127; Wl[t * 129 + s] = Wsp[(size_t)(h * 128 + t) * 128 + s]; }
#pragma unroll
        for (int k = 0; k < 2; ++k) { const int idx = F.tid + 512 * k, s = idx >> 3, c8 = idx & 7; const v4u w = *(const GAS v4u*)(ZV + (size_t)(row0 + s) * 512 + 64 * h + 8 * c8);
            LAS float* z = Zl + s * 64 + 8 * c8; z[0] = bflo(w.x); z[1] = bfhi(w.x); z[2] = bflo(w.y); z[3] = bfhi(w.y); z[4] = bflo(w.z); z[5] = bfhi(w.z); z[6] = bflo(w.w); z[7] = bfhi(w.w); }
        __syncthreads();
        const int t = F.tid >> 2, cg = F.tid & 3, tmax = F.wave * 16 + 15;
        float acc[16];
#pragma unroll
        for (int j = 0; j < 16; ++j) acc[j] = 0.f;
#pragma unroll 2
        for (int s = 0; s <= tmax; ++s) { const float w = (s <= t) ? Wl[t * 129 + s] : 0.f; const LAS f32x4* z = (const LAS f32x4*)(Zl + s * 64 + 16 * cg);
#pragma unroll
            for (int j = 0; j < 4; ++j) { const f32x4 zz = z[j]; acc[4 * j] += w * zz.x; acc[4 * j + 1] += w * zz.y; acc[4 * j + 2] += w * zz.z; acc[4 * j + 3] += w * zz.w; } }
        const float bsv = bsp[h * 128 + t];
        GAS v4u* mp = (GAS v4u*)(MIX + (size_t)(row0 + t) * 1024 + 64 * h + 16 * cg);
#pragma unroll
        for (int j = 0; j < 2; ++j) { const v4u zu = mp[j]; v4u o;
            o.x = pk2(bflo(zu.x) * (acc[8 * j + 0] + bsv), bfhi(zu.x) * (acc[8 * j + 1] + bsv)); o.y = pk2(bflo(zu.y) * (acc[8 * j + 2] + bsv), bfhi(zu.y) * (acc[8 * j + 3] + bsv));
            o.z = pk2(bflo(zu.z) * (acc[8 * j + 4] + bsv), bfhi(zu.z) * (acc[8 * j + 5] + bsv)); o.w = pk2(bflo(zu.w) * (acc[8 * j + 6] + bsv), bfhi(zu.w) * (acc[8 * j + 7] + bsv));
            mp[j] = o; }
        __syncthreads();
    }
}
__device__ __forceinline__ void p2_attn_prompt(Frame& F, ArgsP a, int layer) {
    typedef short bf16x8_t __attribute__((ext_vector_type(8))); typedef short bf16x4_t __attribute__((ext_vector_type(4)));
    constexpr int KST = 144, VST = 560, VT_OFF = 272 * KST;
    LAS unsigned char* Kl = F.lds; LAS unsigned char* Vt = F.lds + VT_OFF;
    bf16* MIX = (bf16*)(a->ws + WS_MIX); const bf16* KB = (const bf16*)(a->ws + WS_KB); const bf16* VB = (const bf16*)(a->ws + WS_VB);
    const float* sinks = a->in[10] + layer * 8;
    const int fr = F.lane & 15, fq = F.lane >> 4;
#pragma unroll 1
    for (int item = F.vcu; item < 256; item += F.G) {
        const int kvh = item & 1, nb = (item >> 1) & 31, b = item >> 6, rowq0 = b * 4096 + nb * 128;
#pragma unroll
        for (int k = 0; k < 4; ++k) { const int idx = F.tid + 512 * k, i = idx >> 3, c8 = idx & 7; const bool valid = (nb > 0) || (i >= 128);
            v4u kk = (v4u){0u, 0u, 0u, 0u}, vv = kk;
            if (valid) { const size_t off = (size_t)(rowq0 - 128 + i) * 128 + 64 * kvh + 8 * c8; kk = *(const GAS v4u*)(KB + off); vv = *(const GAS v4u*)(VB + off); }
            *(LAS v4u*)(Kl + i * KST + c8 * 16) = kk;
            LAS unsigned short* vp = (LAS unsigned short*)(Vt + (8 * c8) * VST + i * 2);
            vp[0 * (VST / 2)] = (unsigned short)(vv.x & 0xffffu); vp[1 * (VST / 2)] = (unsigned short)(vv.x >> 16); vp[2 * (VST / 2)] = (unsigned short)(vv.y & 0xffffu); vp[3 * (VST / 2)] = (unsigned short)(vv.y >> 16);
            vp[4 * (VST / 2)] = (unsigned short)(vv.z & 0xffffu); vp[5 * (VST / 2)] = (unsigned short)(vv.z >> 16); vp[6 * (VST / 2)] = (unsigned short)(vv.w & 0xffffu); vp[7 * (VST / 2)] = (unsigned short)(vv.w >> 16); }
        if (F.tid < 144) *(LAS v4u*)(Kl + 256 * KST + F.tid * 16) = (v4u){0u, 0u, 0u, 0u};
        if (F.tid >= 256 && F.tid < 448) { const int u = F.tid - 256; *(LAS v4u*)(Vt + (u / 3) * VST + 512 + (u % 3) * 16) = (v4u){0u, 0u, 0u, 0u}; }
        __syncthreads();
        const int g = F.wave >> 1, qh = F.wave & 1, head = 4 * kvh + g; const float sink = sinks[head]; const int kmin = (nb == 0) ? 128 : 0;
#pragma unroll 1
        for (int gq = 0; gq < 4; ++gq) {
            const int qbase = 64 * qh + 16 * gq; bf16* qrow = MIX + (size_t)(rowq0 + qbase + fr) * 1024 + 512 + 64 * head;
            const bf16x8_t q0 = *(const GAS bf16x8_t*)(qrow + 8 * fq), q1 = *(const GAS bf16x8_t*)(qrow + 32 + 8 * fq);
            f32x4 s[10];
#pragma unroll
            for (int tt = 0; tt < 10; ++tt) { const LAS unsigned char* kp = Kl + (qbase + 16 * tt + fr) * KST + fq * 16;
                const bf16x8_t k0 = *(const LAS bf16x8_t*)kp, k1 = *(const LAS bf16x8_t*)(kp + 64);
                f32x4 z = (f32x4){0.f, 0.f, 0.f, 0.f}; z = __builtin_amdgcn_mfma_f32_16x16x32_bf16(k0, q0, z, 0, 0, 0); s[tt] = __builtin_amdgcn_mfma_f32_16x16x32_bf16(k1, q1, z, 0, 0, 0); }
            float mx = sink;
#pragma unroll
            for (int tt = 0; tt < 10; ++tt)
#pragma unroll
                for (int i = 0; i < 4; ++i) { const int rel = 16 * tt + 4 * fq + i - fr; const bool ok = (rel >= 1) && (rel <= 128) && (qbase + fr + rel >= kmin);
                    s[tt][i] = ok ? s[tt][i] : -1e30f; mx = fmaxf(mx, s[tt][i]); }
            mx = fmaxf(mx, __shfl_xor(mx, 16)); mx = fmaxf(mx, __shfl_xor(mx, 32));
            float l = 0.f;
#pragma unroll
            for (int tt = 0; tt < 10; ++tt)
#pragma unroll
                for (int i = 0; i < 4; ++i) { const float p = fexp(s[tt][i] - mx); s[tt][i] = p; l += p; }
            l += __shfl_xor(l, 16); l += __shfl_xor(l, 32); l += fexp(sink - mx);
            f32x4 o[4];
#pragma unroll
            for (int dt = 0; dt < 4; ++dt) o[dt] = (f32x4){0.f, 0.f, 0.f, 0.f};
#pragma unroll
            for (int u = 0; u < 5; ++u) {
                const unsigned p0 = pg8::cvt_pk_bf16(s[2 * u][0], s[2 * u][1]), p1 = pg8::cvt_pk_bf16(s[2 * u][2], s[2 * u][3]), p2 = pg8::cvt_pk_bf16(s[2 * u + 1][0], s[2 * u + 1][1]), p3 = pg8::cvt_pk_bf16(s[2 * u + 1][2], s[2 * u + 1][3]);
                const v4u pw = (v4u){p0, p1, p2, p3}; const bf16x8_t pf = __builtin_bit_cast(bf16x8_t, pw);
#pragma unroll
                for (int dt = 0; dt < 4; ++dt) { const LAS unsigned char* vp = Vt + (16 * dt + fr) * VST + (qbase + 32 * u + 4 * fq) * 2;
                    const bf16x4_t va = *(const LAS bf16x4_t*)vp, vb = *(const LAS bf16x4_t*)(vp + 32);
                    const bf16x8_t vf = (bf16x8_t){va[0], va[1], va[2], va[3], vb[0], vb[1], vb[2], vb[3]};
                    o[dt] = __builtin_amdgcn_mfma_f32_16x16x32_bf16(vf, pf, o[dt], 0, 0, 0); }
            }
            const float inv = 1.f / l;
#pragma unroll
            for (int dt = 0; dt < 4; ++dt) { const unsigned w0 = pg8::cvt_pk_bf16(o[dt][0] * inv, o[dt][1] * inv), w1 = pg8::cvt_pk_bf16(o[dt][2] * inv, o[dt][3] * inv);
                *(GAS unsigned long long*)(qrow + 16 * dt + 4 * fq) = (unsigned long long)w0 | ((unsigned long long)w1 << 32); }
        }
        __syncthreads();
    }
}
__device__ __forceinline__ void p2_sample(Frame& F, ArgsP a, int layer) {
    LAS float* Ks = (LAS float*)F.lds; LAS float* Vs = Ks + 136 * 68; LAS float* Ql = Vs + 136 * 68; LAS float* Sl = Ql + 32 * 64;
    bf16* MIX = (bf16*)(a->ws + WS_MIX); const bf16* ZV = (const bf16*)(a->ws + WS_ZV);
    const float* Wsp = a->in[8] + (size_t)layer * 8 * 128 * 128; const float* bsp = a->in[9] + (size_t)layer * 8 * 128; const float* sinks = a->in[10] + layer * 8;
#pragma unroll 1
    for (int item = F.vcu; item < 256; item += F.G) {
        const int kvh = item & 1, b = item >> 1, srow0 = cfg::MP + b * 8, lb = layer * 128 + b;
        for (int idx = F.tid; idx < 136 * 16; idx += 512) { const int j = idx >> 4, d4 = idx & 15; f32x4 kk, vv;
            if (j < 128) { const size_t off = ((size_t)(lb * 128 + j) * 2 + kvh) * 64 + 4 * d4; kk = *(const GAS f32x4*)(a->in[2] + off); vv = *(const GAS f32x4*)(a->in[3] + off); }
            else { const size_t off = ((size_t)(lb * 128 + 120 + (j - 128)) * 2 + kvh) * 64 + 4 * d4; kk = *(const GAS f32x4*)(a->out + cfg::O_KS + off); vv = *(const GAS f32x4*)(a->out + cfg::O_VS + off); }
            *(LAS f32x4*)(Ks + j * 68 + 4 * d4) = kk; *(LAS f32x4*)(Vs + j * 68 + 4 * d4) = vv; }
        for (int idx = F.tid; idx < 32 * 64; idx += 512) { const int p = idx >> 6, d = idx & 63, t = p >> 2, g = p & 3; Ql[idx] = bf2f(MIX[(size_t)(srow0 + t) * 1024 + 512 + 64 * (4 * kvh + g) + d]); }
        __syncthreads();
        for (int idx = F.tid; idx < 32 * 136; idx += 512) { const int p = idx / 136, j = idx % 136, t = p >> 2; const bool valid = j < 128 ? (j >= t + 1) : (j - 128 <= t);
            float s = 0.f; const LAS f32x4* kr = (const LAS f32x4*)(Ks + j * 68); const LAS f32x4* qr = (const LAS f32x4*)(Ql + p * 64);
#pragma unroll
            for (int d4 = 0; d4 < 16; ++d4) { const f32x4 x = kr[d4], q = qr[d4]; s += q.x * x.x + q.y * x.y + q.z * x.z + q.w * x.w; }
            Sl[p * 137 + j] = valid ? s : -1e30f; }
        __syncthreads();
        { const int p = F.tid >> 4, sub = F.tid & 15, g = p & 3; const float sink = sinks[4 * kvh + g]; float mx = sink;
            for (int j = sub; j < 136; j += 16) mx = fmaxf(mx, Sl[p * 137 + j]);
#pragma unroll
            for (int o = 1; o < 16; o <<= 1) mx = fmaxf(mx, __shfl_xor(mx, o));
            float sum = 0.f;
            for (int j = sub; j < 136; j += 16) { const float e = fexp(Sl[p * 137 + j] - mx); Sl[p * 137 + j] = e; sum += e; }
#pragma unroll
            for (int o = 1; o < 16; o <<= 1) sum += __shfl_xor(sum, o);
            const float inv = 1.f / (sum + fexp(sink - mx));
            for (int j = sub; j < 136; j += 16) Sl[p * 137 + j] *= inv; }
        __syncthreads();
        { const int p = F.tid >> 4, d4 = F.tid & 15, t = p >> 2, g = p & 3; f32x4 o = (f32x4){0.f, 0.f, 0.f, 0.f};
            for (int j = 0; j < 136; ++j) { const float pj = Sl[p * 137 + j]; const f32x4 v = *(const LAS f32x4*)(Vs + j * 68 + 4 * d4); o = o + v * pj; }
            unsigned long long w = (unsigned long long)pk2(o.x, o.y) | ((unsigned long long)pk2(o.z, o.w) << 32);
            *(GAS unsigned long long*)(MIX + (size_t)(srow0 + t) * 1024 + 512 + 64 * (4 * kvh + g) + 4 * d4) = w; }
        { const int t = F.tid >> 6, hh = (F.tid >> 4) & 3, c4 = (F.tid & 15) * 4, h = 4 * kvh + hh; f32x4 f = (f32x4){0.f, 0.f, 0.f, 0.f};
            for (int s = 0; s <= t; ++s) { const float w = Wsp[(size_t)(h * 128 + t) * 128 + s]; const unsigned long long z = *(const GAS unsigned long long*)(ZV + (size_t)(srow0 + s) * 512 + 64 * h + c4);
                f.x += w * bflo((unsigned)z); f.y += w * bfhi((unsigned)z); f.z += w * bflo((unsigned)(z >> 32)); f.w += w * bfhi((unsigned)(z >> 32)); }
            const float bsv = bsp[h * 128 + t]; GAS unsigned long long* mp = (GAS unsigned long long*)(MIX + (size_t)(srow0 + t) * 1024 + 64 * h + c4); const unsigned long long zu = *mp;
            *mp = (unsigned long long)pk2(bflo((unsigned)zu) * (f.x + bsv), bfhi((unsigned)zu) * (f.y + bsv)) | ((unsigned long long)pk2(bflo((unsigned)(zu >> 32)) * (f.z + bsv), bfhi((unsigned)(zu >> 32)) * (f.w + bsv)) << 32); }
        __syncthreads();
    }
}
__device__ __forceinline__ void p4_fixup(Frame& F, ArgsP a, int layer) {
    const float* HF = (const float*)(a->ws + WS_HF); const float* HL = (const float*)(a->ws + WS_HL); bf16* ACT = (bf16*)(a->ws + WS_ACT);
    const float* cw = a->in[15] + (size_t)layer * 3 * cfg::NUP; const float* cb = a->in[16] + (size_t)layer * cfg::NUP;
#pragma unroll 1
    for (int e = F.vcu * 512 + F.tid; e < 256 * cfg::FF; e += F.G * 512) {
        const int q = e / cfg::FF, c = e % cfg::FF; if ((q & 63) == 0) continue;
        float hcv[2][2];
#pragma unroll
        for (int half = 0; half < 2; ++half) { const int col = half * cfg::FF + c;
            const float um2 = HL[(size_t)((q - 1) * 2) * 5632 + col], um1 = HL[(size_t)((q - 1) * 2 + 1) * 5632 + col], u0 = HF[(size_t)(q * 2) * 5632 + col], u1 = HF[(size_t)(q * 2 + 1) * 5632 + col];
            const float w0 = cw[col], w1 = cw[5632 + col], w2 = cw[2 * 5632 + col], b0 = cb[col];
            hcv[half][0] = b0 + w0 * um2 + w1 * um1 + w2 * u0; hcv[half][1] = b0 + w0 * um1 + w1 * u0 + w2 * u1; }
        ACT[(size_t)(q * 64) * cfg::FF + c] = (bf16)f2bf(gelu1(hcv[0][0]) * hcv[1][0]);
        ACT[(size_t)(q * 64 + 1) * cfg::FF + c] = (bf16)f2bf(gelu1(hcv[0][1]) * hcv[1][1]);
    }
    const float* UPS = (const float*)(a->ws + WS_UPS); const float* cconv = a->in[4] + (size_t)layer * 128 * 2 * cfg::NUP;
#pragma unroll 1
    for (int e = F.vcu * 512 + F.tid; e < cfg::MS * cfg::FF; e += F.G * 512) {
        const int s = e / cfg::FF, c = e % cfg::FF, b = s >> 3, t = s & 7; float hcv[2];
#pragma unroll
        for (int half = 0; half < 2; ++half) { const int col = half * cfg::FF + c;
            const float u0 = UPS[(size_t)s * 5632 + col];
            const float um1 = t >= 1 ? UPS[(size_t)(s - 1) * 5632 + col] : cconv[(size_t)(b * 2 + 1) * 5632 + col];
            const float um2 = t >= 2 ? UPS[(size_t)(s - 2) * 5632 + col] : cconv[(size_t)(b * 2 + t) * 5632 + col];
            hcv[half] = cb[col] + cw[col] * um2 + cw[5632 + col] * um1 + cw[2 * 5632 + col] * u0; }
        ACT[(size_t)(cfg::MP + s) * cfg::FF + c] = (bf16)f2bf(gelu1(hcv[0]) * hcv[1]);
    }
#pragma unroll 2
    for (int e = F.vcu * 512 + F.tid; e < 128 * 2 * cfg::NUP; e += F.G * 512) {
        const int b = e / (2 * cfg::NUP), r = e % (2 * cfg::NUP), j = r / cfg::NUP, col = r % cfg::NUP;
        a->out[cfg::O_CS + (size_t)((layer * 128 + b) * 2 + j) * 5632 + col] = UPS[(size_t)(b * 8 + 6 + j) * 5632 + col]; }
}

__device__ __forceinline__ int lane_id() { unsigned ones = ~0u; asm volatile("" : "+s"(ones) :: "memory"); return (int)__builtin_amdgcn_mbcnt_hi(ones, __builtin_amdgcn_mbcnt_lo(ones, 0u)); }
__device__ __forceinline__ void make_frame(Frame& F, LAS unsigned char* lds, const int wave_s) {
    const int l = lane_id();
    F.lds = lds; F.MISC = (volatile LAS unsigned*)(lds + MISC_OFF); F.tid = wave_s * 64 + l; F.lane = l; F.wave = wave_s;
    F.G = gridDim.x; { const int bx = blockIdx.x; F.vcu = (F.G % 8 == 0) ? (bx % 8) * (F.G / 8) + bx / 8 : bx; }
}
__device__ __forceinline__ ArgsP get_args() { ArgsP p = (ArgsP)__builtin_amdgcn_kernarg_segment_ptr(); asm volatile("" : "+s"(p) :: "memory"); return p; }
__device__ __forceinline__ void grid_bar(LAS unsigned char* lds, const int wave_s) {
    ArgsP a = get_args(); XcdBarrier b; b.bar = (unsigned*)(a->ws + WS_CTL) + CW_BAR; b.x = xb_xcc_id(); b.st = (volatile LAS unsigned*)(lds + MISC_OFF) + 8; xcd_barrier(b, wave_s == 0 && lane_id() == 0);
}
#define GRID_BAR() grid_bar(lds, wave_s)
#define PHASE_BEGIN Frame F; make_frame(F, lds, wave_s); ArgsP a = get_args(); unsigned char* ws = a->ws; (void)ws; (void)F;
template <int LAYER> __device__ __forceinline__ void run_layer(LAS unsigned char* lds, const int wave_s) {
    constexpr int layer = LAYER;
#ifndef SKIP_P1
        {
            PHASE_BEGIN const unsigned char* wl = ws + WS_W + (size_t)layer * W_LAYER;
            pg8::Gemm g{(const pg8::bf16_t*)(ws + WS_XB), (const pg8::bf16_t*)(wl + W_IN), cfg::M, cfg::NIN, cfg::D}; pg8::StaticOrder S; S.init(cfg::M, cfg::NIN, F.G, (int)blockIdx.x);
            pg8::EpiIn E{(bf16*)(ws + WS_MIX), (bf16*)(ws + WS_ZV), (bf16*)(ws + WS_KB), (bf16*)(ws + WS_VB), (const float*)(ws + WS_ROPE), a->in[6] + layer * 512, a->in[7] + layer * 512, a->out, layer};
            pg8::gemm_phase<pg8::EpiIn, pg8::StaticOrder, true, true>(F.lds + RING_OFF, g, S, E, wave_s);
        }
#endif
        GRID_BAR();
#ifndef SKIP_P2A
        { PHASE_BEGIN p2_gmlp_prompt(F, a, layer); }
#endif
#ifndef SKIP_P2B
        { PHASE_BEGIN p2_attn_prompt(F, a, layer); }
#endif
#ifndef SKIP_P2C
        { PHASE_BEGIN p2_sample(F, a, layer); }
#endif
        GRID_BAR();
#ifndef SKIP_P3
        {
            PHASE_BEGIN const unsigned char* wl = ws + WS_W + (size_t)layer * W_LAYER; float* Y = a->out + cfg::O_Y;
            pg8::Gemm g{(const pg8::bf16_t*)(ws + WS_MIX), (const pg8::bf16_t*)(wl + W_OUT), cfg::M, cfg::D, cfg::D}; pg8::StaticOrder S; S.init(cfg::M, cfg::D, F.G, (int)blockIdx.x);
            pg8::EpiRes E{layer == 0 ? a->in[0] : (const float*)Y, layer == 0 ? a->in[1] : (const float*)(Y + (size_t)cfg::MP * 1024), Y};
            pg8::gemm_phase<pg8::EpiRes, pg8::StaticOrder, true, true>(F.lds + RING_OFF, g, S, E, wave_s);
        }
#endif
        GRID_BAR();
        { PHASE_BEGIN ln_rows(F, a->out + cfg::O_Y, (bf16*)(ws + WS_XB), a->in[12] + layer * 1024, a->in[13] + layer * 1024); }
        GRID_BAR();
#ifndef SKIP_P4
        {
            PHASE_BEGIN const unsigned char* wl = ws + WS_W + (size_t)layer * W_LAYER;
            pg8::Gemm g{(const pg8::bf16_t*)(ws + WS_XB), (const pg8::bf16_t*)(wl + W_UP), cfg::M, cfg::NUP, cfg::D}; pg8::StaticOrder S; S.init(cfg::M, cfg::NUP, F.G, (int)blockIdx.x);
            pg8::EpiUp E{(bf16*)(ws + WS_ACT), a->in[15] + (size_t)layer * 3 * cfg::NUP, a->in[16] + (size_t)layer * cfg::NUP, (float*)(ws + WS_UPS), a->out,
                         (float*)(ws + WS_HF), (float*)(ws + WS_HL), F.lds + XCH_OFF, layer};
            pg8::gemm_phase<pg8::EpiUp, pg8::StaticOrder, true, true>(F.lds + RING_OFF, g, S, E, wave_s);
        }
#endif
        GRID_BAR();
        { PHASE_BEGIN p4_fixup(F, a, layer); }
        GRID_BAR();
#ifndef SKIP_P5
        {
            PHASE_BEGIN const unsigned char* wl = ws + WS_W + (size_t)layer * W_LAYER; float* Y = a->out + cfg::O_Y;
            pg8::Gemm g{(const pg8::bf16_t*)(ws + WS_ACT), (const pg8::bf16_t*)(wl + W_DOWN), cfg::M, cfg::D, cfg::FF}; pg8::StaticOrder S; S.init(cfg::M, cfg::D, F.G, (int)blockIdx.x);
            pg8::EpiRes E{(const float*)Y, (const float*)(Y + (size_t)cfg::MP * 1024), Y};
            pg8::gemm_phase<pg8::EpiRes, pg8::StaticOrder, true, true>(F.lds + RING_OFF, g, S, E, wave_s);
        }
#endif
        GRID_BAR();
        { PHASE_BEGIN ln_rows(F, a->out + cfg::O_Y, (bf16*)(ws + WS_XB), a->in[18] + layer * 1024, a->in[19] + layer * 1024); }
        if (layer == 0) GRID_BAR();
}
__global__ void __launch_bounds__(NWAVES * 64, 2) trunk_fwd(Args args_by_kernarg_segment) {
    extern __shared__ __attribute__((aligned(16))) unsigned char lds_[];
    LAS unsigned char* lds = (LAS unsigned char*)lds_;
    const int wave_s = __builtin_amdgcn_readfirstlane(threadIdx.x >> 6);
    for (int u = wave_s * 64 + lane_id(); u < (LDS_BYTES - LDSCTL_OFF) / 4; u += NWAVES * 64) ((LAS unsigned*)(lds + LDSCTL_OFF))[u] = 0u;
    __syncthreads();
    { ArgsP a = get_args(); (void)xcd_barrier_post((unsigned*)(a->ws + WS_CTL) + CW_BAR, (volatile LAS unsigned*)(lds + MISC_OFF) + 8, wave_s == 0 && lane_id() == 0); }
#ifndef SKIP_P0
    { PHASE_BEGIN p0_prologue(F, a); }
#endif
    GRID_BAR();
    run_layer<0>(lds, wave_s);
    run_layer<1>(lds, wave_s);
}

extern "C" void kernel_launch(void* const* d_in, const int* in_sizes, int n_in, void* d_out, int out_size, void* d_ws, size_t ws_size, hipStream_t stream) {
    static int grid = 0;
    if (grid == 0) {
        if (n_in != 20 || out_size != (int)cfg::O_END || ws_size < WS_END) { fprintf(stderr, "kernel_launch: unexpected shapes (n_in %d, out %d, ws %zu); nothing launched\n", n_in, out_size, ws_size); grid = -1; return; }
        int dev = 0, cus = 0;
        if (hipGetDevice(&dev) != hipSuccess || hipDeviceGetAttribute(&cus, hipDeviceAttributeMultiprocessorCount, dev) != hipSuccess) { grid = -1; return; }
        if (hipFuncSetAttribute((const void*)trunk_fwd, hipFuncAttributeMaxDynamicSharedMemorySize, LDS_BYTES) != hipSuccess) { fprintf(stderr, "kernel_launch: hipFuncSetAttribute failed\n"); grid = -1; return; }
        (void)hipGetLastError();
        grid = cus;
    }
    if (grid < 0) return;
    if (hipMemsetAsync((char*)d_ws + WS_CTL, 0, CTL_ZERO_BYTES, stream) != hipSuccess) { fprintf(stderr, "kernel_launch: hipMemsetAsync failed\n"); return; }
    Args a{};
    for (int i = 0; i < 20; ++i) a.in[i] = (const float*)d_in[i];
    a.out = (float*)d_out; a.ws = (unsigned char*)d_ws;
    for (int i = 0; i < 32; ++i) a.inv_freq[i] = (float)pow(10000.0, -(double)i / 32.0);
    hipLaunchKernelGGL(trunk_fwd, dim3(grid), dim3(NWAVES * 64), LDS_BYTES, stream, a);
}
```
